# Optimizing an MI355X kernel written in HIP

```python
import jax, jax.numpy as jnp
from jax import lax
import numpy as np

D_MODEL = 1024
BATCH = 4
SEQ = 4096
DEPTH = 2

GRID_W = 64
CTX_LEN = 256
EPS = 1e-6
NEG_INF = -1e30

HEAD_DIM = 64
N_Q_HEADS = (D_MODEL // 2) // HEAD_DIM
N_KV_HEADS = N_Q_HEADS // 4
Q_GROUP = N_Q_HEADS // N_KV_HEADS
WINDOW = 128
BLOCK = 128
ROPE_BASE = 10000.0
ATT_WIDTH = N_Q_HEADS * HEAD_DIM
KV_WIDTH = N_KV_HEADS * HEAD_DIM
GM_WIDTH = D_MODEL // 2
GM_GROUPS = 8
GM_GROUP_DIM = GM_WIDTH // GM_GROUPS
CHUNK = 128
Q_END = ATT_WIDTH
KV_END = Q_END + 2 * KV_WIDTH
IN_WIDTH = KV_END + 2 * GM_WIDTH
MIX_WIDTH = ATT_WIDTH + GM_WIDTH
POOL_SIZES = (2, 4, 8, 16)
POOL_GROUPS = len(POOL_SIZES)
POOL_GROUP_DIM = D_MODEL // POOL_GROUPS
D_FF_DENSE = 256 * ((8 * D_MODEL // 3 + 255) // 256)
N_EXPERTS = 8
TOP_K = 2
D_FF_EXPERT = 7 * D_MODEL // 2
N_EVEN = (DEPTH + 1) // 2
N_ODD = DEPTH // 2

kernel_name = "hybrid_window_gmlp_pool_moe_dit"


def _rms_normalize(x):
    xf = x.astype(jnp.float32)
    y = xf * lax.rsqrt(jnp.mean(xf * xf, axis=-1, keepdims=True) + EPS)
    return y.astype(x.dtype)


def _modulate(x, shift, scale):
    return _rms_normalize(x) * (1 + scale) + shift


def _axial_rope_tables(n_tokens):
    rows = n_tokens // GRID_W
    row_pos = jnp.repeat(jnp.arange(rows, dtype=jnp.float32), GRID_W)
    col_pos = jnp.tile(jnp.arange(GRID_W, dtype=jnp.float32), rows)
    axis_dim = HEAD_DIM // 2
    inv_freq = ROPE_BASE ** (-jnp.arange(0, axis_dim, 2, dtype=jnp.float32) / axis_dim)
    ang = jnp.stack([row_pos[:, None] * inv_freq, col_pos[:, None] * inv_freq], axis=1)
    return jnp.cos(ang), jnp.sin(ang)


def _apply_axial_rope(t, cos, sin):
    shp = t.shape
    tr = t.reshape(shp[:-1] + (2, 2, HEAD_DIM // 4))
    t1, t2 = tr[..., 0, :], tr[..., 1, :]
    cs = cos[:, None].astype(t.dtype)
    sn = sin[:, None].astype(t.dtype)
    out = jnp.stack([t1 * cs - t2 * sn, t2 * cs + t1 * sn], axis=-2)
    return out.reshape(shp)


def _softmax_with_sink(scores, sink_l):
    m = jnp.maximum(jnp.max(scores, axis=-1, keepdims=True), sink_l)
    p = jnp.exp(scores - m)
    return p / (jnp.sum(p, axis=-1, keepdims=True) + jnp.exp(sink_l - m))


def _window_attention_with_context(q, k, v, kc, vc, sink):
    B, S = q.shape[0], q.shape[1]
    nb = S // BLOCK
    qb = q.reshape(B, nb, BLOCK, N_KV_HEADS, Q_GROUP, HEAD_DIM) * (HEAD_DIM ** -0.5)

    def band(t):
        tp = jnp.pad(t, ((0, 0), (BLOCK, BLOCK), (0, 0), (0, 0)))
        tp = tp.reshape(B, nb + 2, BLOCK, N_KV_HEADS, HEAD_DIM)
        return jnp.concatenate([tp[:, :-2], tp[:, 1:-1], tp[:, 2:]], axis=2)

    kb, vb = band(k), band(v)
    qpos = jnp.arange(nb)[:, None, None] * BLOCK + jnp.arange(BLOCK)[None, :, None]
    kpos = (jnp.arange(nb)[:, None, None] - 1) * BLOCK + jnp.arange(3 * BLOCK)[None, None, :]
    mask = (jnp.abs(kpos - qpos) <= WINDOW) & (kpos >= 0) & (kpos < S)
    s_loc = jnp.einsum('bnqhgd,bnkhd->bnhgqk', qb, kb).astype(jnp.float32)
    s_loc = jnp.where(mask[None, :, None, None], s_loc, NEG_INF)
    s_ctx = jnp.einsum('bnqhgd,bchd->bnhgqc', qb, kc).astype(jnp.float32)
    scores = jnp.concatenate([s_loc, s_ctx], axis=-1)
    sink_l = sink.astype(jnp.float32).reshape(1, 1, N_KV_HEADS, Q_GROUP, 1, 1)
    p = _softmax_with_sink(scores, sink_l).astype(v.dtype)
    out = (jnp.einsum('bnhgqk,bnkhd->bnqhgd', p[..., :3 * BLOCK], vb)
           + jnp.einsum('bnhgqc,bchd->bnqhgd', p[..., 3 * BLOCK:], vc))
    return out.reshape(B, S, ATT_WIDTH)


def _context_attention(qc, kc, vc, sink):
    B, L = qc.shape[0], qc.shape[1]
    qg = qc.reshape(B, L, N_KV_HEADS, Q_GROUP, HEAD_DIM) * (HEAD_DIM ** -0.5)
    s = jnp.einsum('blhgd,bchd->bhglc', qg, kc).astype(jnp.float32)
    sink_l = sink.astype(jnp.float32).reshape(1, N_KV_HEADS, Q_GROUP, 1, 1)
    p = _softmax_with_sink(s, sink_l).astype(vc.dtype)
    return jnp.einsum('bhglc,bchd->blhgd', p, vc).reshape(B, L, ATT_WIDTH)


def _spatial_gating(u, v, gain, w_s, b_s):
    B, S = u.shape[0], u.shape[1]
    v = _rms_normalize(v) * gain
    vg = v.reshape(B, S // CHUNK, CHUNK, GM_GROUPS, GM_GROUP_DIM)
    mixed = jnp.einsum('gts,bnsgd->bntgd', w_s, vg) + b_s.T[:, :, None]
    return u * mixed.reshape(B, S, GM_WIDTH)


def _attn_gmlp_mixer(hx, hc, cos, sin, w_in, sink, gm_gain, w_s, b_s, w_out, with_ctx_out):
    B, S = hx.shape[0], hx.shape[1]
    proj = hx @ w_in
    q = proj[..., :Q_END].reshape(B, S, N_Q_HEADS, HEAD_DIM)
    k = proj[..., Q_END:Q_END + KV_WIDTH].reshape(B, S, N_KV_HEADS, HEAD_DIM)
    v = proj[..., Q_END + KV_WIDTH:KV_END].reshape(B, S, N_KV_HEADS, HEAD_DIM)
    u_gm, v_gm = jnp.split(jax.nn.gelu(proj[..., KV_END:]), 2, axis=-1)
    q = _apply_axial_rope(q, cos, sin)
    k = _apply_axial_rope(k, cos, sin)
    L = hc.shape[1]
    kv_c = hc @ w_in[:, Q_END:KV_END]
    kc = kv_c[..., :KV_WIDTH].reshape(B, L, N_KV_HEADS, HEAD_DIM)
    vc = kv_c[..., KV_WIDTH:].reshape(B, L, N_KV_HEADS, HEAD_DIM)
    att = _window_attention_with_context(q, k, v, kc, vc, sink)
    gm = _spatial_gating(u_gm, v_gm, gm_gain, w_s, b_s)
    out_x = jnp.concatenate([att, gm], axis=-1) @ w_out
    if with_ctx_out:
        qc = (hc @ w_in[:, :Q_END]).reshape(B, L, N_Q_HEADS, HEAD_DIM)
        uc, vgc = jnp.split(jax.nn.gelu(hc @ w_in[:, KV_END:]), 2, axis=-1)
        att_c = _context_attention(qc, kc, vc, sink)
        gm_c = _spatial_gating(uc, vgc, gm_gain, w_s, b_s)
        return out_x, jnp.concatenate([att_c, gm_c], axis=-1) @ w_out
    return out_x, None


def _multiscale_pool(h, w_pool, scale):
    B, S, D = h.shape
    hg = h.reshape(B, S, POOL_GROUPS, POOL_GROUP_DIM)
    t = jnp.arange(S)
    outs = []
    for gi, w in enumerate(POOL_SIZES):
        seg = hg[:, :, gi].astype(jnp.float32)
        cs = jnp.pad(jnp.cumsum(seg, axis=1), ((0, 0), (1, 0), (0, 0)))
        lo = jnp.maximum(t - w // 2, 0)
        hi = jnp.minimum(t + (w - 1 - w // 2), S - 1) + 1
        mean = (cs[:, hi] - cs[:, lo]) / (hi - lo).astype(jnp.float32)[None, :, None]
        outs.append((mean - seg).astype(h.dtype))
    diff = jnp.stack(outs, axis=2)
    y = jnp.einsum('bsgc,gcd->bsgd', diff, w_pool).reshape(B, S, D)
    return y * scale


def _swiglu(h, w_gate, w_up, w_down):
    return (jax.nn.silu(h @ w_gate) * (h @ w_up)) @ w_down


def _moe_swiglu(h, w_router, w_gate, w_up, w_down):
    B, S, D = h.shape
    tok = h.reshape(-1, D)
    n = tok.shape[0]
    logits = (tok @ w_router).astype(jnp.float32)
    top_val, top_idx = lax.top_k(logits, TOP_K)
    weights = jax.nn.softmax(top_val, axis=-1)
    flat_e = top_idx.reshape(-1)
    order = jnp.argsort(flat_e)
    token_of = order // TOP_K
    xs = tok[token_of]
    group_sizes = jnp.bincount(flat_e, length=N_EXPERTS).astype(jnp.int32)
    g = lax.ragged_dot(xs, w_gate, group_sizes)
    u = lax.ragged_dot(xs, w_up, group_sizes)
    y = lax.ragged_dot(jax.nn.silu(g) * u, w_down, group_sizes)
    y = y * weights.reshape(-1)[order][:, None].astype(y.dtype)
    out = jax.ops.segment_sum(y, token_of, num_segments=n)
    return out.reshape(B, S, D)


def setup_inputs(seed: int = 0) -> dict:
    key = jax.random.key(seed)
    ks = jax.random.split(key, 24)
    D = D_MODEL
    f32 = jnp.float32
    nrm = lambda k, shp, s: jax.random.normal(k, shp, f32) * s
    return {
        "x": nrm(ks[0], (BATCH, SEQ, D), 1.0),
        "c": nrm(ks[1], (BATCH, D), 1.0),
        "ctx": nrm(ks[2], (BATCH, CTX_LEN, D), 1.0),
        "c_ctx": nrm(ks[3], (D,), 1.0),
        "w_ada": nrm(ks[4], (DEPTH, D, 6 * D), D ** -0.5),
        "b_ada": nrm(ks[5], (DEPTH, 6 * D), 0.02),
        "w_in": nrm(ks[6], (N_EVEN, D, IN_WIDTH), D ** -0.5),
        "attn_sink": nrm(ks[7], (N_EVEN, N_Q_HEADS), 1.0),
        "gm_gain": 1.0 + nrm(ks[8], (N_EVEN, GM_WIDTH), 0.1),
        "gm_w_s": nrm(ks[9], (N_EVEN, GM_GROUPS, CHUNK, CHUNK), CHUNK ** -0.5),
        "gm_b_s": 1.0 + nrm(ks[10], (N_EVEN, GM_GROUPS, CHUNK), 0.1),
        "w_out": nrm(ks[11], (N_EVEN, MIX_WIDTH, D), MIX_WIDTH ** -0.5),
        "ffn_w_gate": nrm(ks[12], (N_EVEN, D, D_FF_DENSE), D ** -0.5),
        "ffn_w_up": nrm(ks[13], (N_EVEN, D, D_FF_DENSE), D ** -0.5),
        "ffn_w_down": nrm(ks[14], (N_EVEN, D_FF_DENSE, D), D_FF_DENSE ** -0.5),
        "pool_w": nrm(ks[15], (N_ODD, POOL_GROUPS, POOL_GROUP_DIM, POOL_GROUP_DIM), POOL_GROUP_DIM ** -0.5),
        "pool_scale": 1.0 + nrm(ks[16], (N_ODD, D), 0.1),
        "router_w": nrm(ks[17], (N_ODD, D, N_EXPERTS), D ** -0.5),
        "moe_w_gate": nrm(ks[18], (N_ODD, N_EXPERTS, D, D_FF_EXPERT), D ** -0.5),
        "moe_w_up": nrm(ks[19], (N_ODD, N_EXPERTS, D, D_FF_EXPERT), D ** -0.5),
        "moe_w_down": nrm(ks[20], (N_ODD, N_EXPERTS, D_FF_EXPERT, D), D_FF_EXPERT ** -0.5),
        "final_gain": 1.0 + nrm(ks[21], (D,), 0.1),
    }


def reference(x, c, ctx, c_ctx, w_ada, b_ada, w_in, attn_sink, gm_gain, gm_w_s, gm_b_s, w_out,
              ffn_w_gate, ffn_w_up, ffn_w_down, pool_w, pool_scale, router_w,
              moe_w_gate, moe_w_up, moe_w_down, final_gain):
    S = x.shape[1]
    cos, sin = _axial_rope_tables(S)
    s_c = jax.nn.silu(c)
    s_cc = jax.nn.silu(c_ctx)
    for layer in range(DEPTH):
        even = layer % 2 == 0
        i = layer // 2
        advance_ctx = any(j % 2 == 0 for j in range(layer + 1, DEPTH))
        mx = jnp.split((s_c @ w_ada[layer] + b_ada[layer])[:, None, :], 6, axis=-1)
        if even or advance_ctx:
            mc = jnp.split(s_cc @ w_ada[layer] + b_ada[layer], 6)
        if even:
            hx = _modulate(x, mx[0], mx[1])
            hc = _modulate(ctx, mc[0], mc[1])
            yx, yc = _attn_gmlp_mixer(hx, hc, cos, sin, w_in[i], attn_sink[i], gm_gain[i],
                                      gm_w_s[i], gm_b_s[i], w_out[i], advance_ctx)
            x = x + mx[2] * yx
            x = x + mx[5] * _swiglu(_modulate(x, mx[3], mx[4]), ffn_w_gate[i], ffn_w_up[i], ffn_w_down[i])
            if advance_ctx:
                ctx = ctx + mc[2] * yc
                ctx = ctx + mc[5] * _swiglu(_modulate(ctx, mc[3], mc[4]),
                                            ffn_w_gate[i], ffn_w_up[i], ffn_w_down[i])
        else:
            x = x + mx[2] * _multiscale_pool(_modulate(x, mx[0], mx[1]), pool_w[i], pool_scale[i])
            x = x + mx[5] * _moe_swiglu(_modulate(x, mx[3], mx[4]), router_w[i],
                                        moe_w_gate[i], moe_w_up[i], moe_w_down[i])
            if advance_ctx:
                ctx = ctx + mc[2] * _multiscale_pool(_modulate(ctx, mc[0], mc[1]), pool_w[i], pool_scale[i])
                ctx = ctx + mc[5] * _moe_swiglu(_modulate(ctx, mc[3], mc[4]), router_w[i],
                                                moe_w_gate[i], moe_w_up[i], moe_w_down[i])
    return _rms_normalize(x) * final_gain
```

```cpp
#include <hip/hip_runtime.h>
#include <cstdio>
#include <cstdint>

#ifndef MK_ONE_LAUNCH
#define MK_ONE_LAUNCH 1
#endif

#define LAS __attribute__((address_space(3)))
#define GAS __attribute__((address_space(1)))
typedef unsigned short bf16_t;
typedef short bf16x8 __attribute__((ext_vector_type(8)));
typedef float f32x2 __attribute__((ext_vector_type(2)));
typedef float f32x4 __attribute__((ext_vector_type(4)));
typedef float f32x16 __attribute__((ext_vector_type(16)));
typedef unsigned u32x2 __attribute__((ext_vector_type(2)));
typedef unsigned u32x4 __attribute__((ext_vector_type(4)));
typedef int i32x4 __attribute__((ext_vector_type(4)));
typedef int i32x8 __attribute__((ext_vector_type(8)));

constexpr int NB = 4, SEQ = 4096, DM = 1024, MTOK = NB * SEQ;
constexpr int CTXL = 256, MCTX = NB * CTXL;
constexpr int INW = 1792;
constexpr int FFD = 2816, FFE = 3584, NEXP = 8, NPAIR = MTOK * 2;
constexpr float EPS = 1e-6f, LOG2E = 1.4426950408889634f;
constexpr float QSCALE = 0.125f * LOG2E;

constexpr size_t MiB = 1u << 20;
constexpr size_t WS_CTL = 0, CTL_ZERO_BYTES = 1 * MiB;
constexpr size_t WS_MOD = 1 * MiB;
constexpr size_t WS_ROPE = 1 * MiB + 256 * 1024;
constexpr size_t WS_RTE = 1 * MiB + 320 * 1024;
constexpr size_t WS_RTW = 1 * MiB + 448 * 1024;
constexpr size_t WS_POS = 2 * MiB;
constexpr size_t WS_CNTB = 2 * MiB + 256 * 1024;
constexpr size_t WS_TOT = 2 * MiB + 320 * 1024;
constexpr size_t WS_PART = 3 * MiB;
constexpr size_t WS_SSQ2 = WS_PART + 1 * MiB;
constexpr size_t WS_SSQ = WS_PART;
constexpr size_t WS_WIN = 11 * MiB;
constexpr size_t WS_WOUT = 15 * MiB;
constexpr size_t WS_WGU = 17 * MiB;
constexpr size_t WS_WDN = 28 * MiB;
constexpr size_t WS_WPOOL = 34 * MiB;
constexpr size_t WS_HC = 35 * MiB;
constexpr size_t WS_H = 37 * MiB;
constexpr size_t WS_WMGU = 69 * MiB;
constexpr size_t WS_XS = 125 * MiB;
constexpr size_t WS_WMDN = 181 * MiB;
constexpr size_t WS_BIG = 237 * MiB;
constexpr size_t WS_PROJ = WS_BIG;
constexpr size_t WS_KVC = WS_BIG + 56 * MiB;
constexpr size_t WS_MIX = WS_BIG + 64 * MiB;
constexpr size_t WS_ACTF = WS_BIG + 96 * MiB;
constexpr size_t WS_DIFF = WS_BIG;
constexpr size_t WS_Y = WS_BIG + 128 * MiB;
constexpr size_t WS_YS = WS_BIG + 196 * MiB;
constexpr size_t WS_XR = 461 * MiB;
constexpr size_t WS_END = 493 * MiB;
constexpr int CW_BAR = 4096;

constexpr int RING_BYTES = 131072, LDSCTL_OFF = 139264, LDS_BYTES = 143360;
constexpr int MAXROWS = NPAIR + 8 * 256;

#define LDS_WAIT() asm volatile("s_waitcnt lgkmcnt(0)" ::: "memory")
#define VM_WAIT() asm volatile("s_waitcnt vmcnt(0)" ::: "memory")

typedef __bf16 bf16x2_t __attribute__((ext_vector_type(2)));
__device__ __forceinline__ unsigned cvt_pk_bf16(float lo, float hi) { const f32x2 v = {lo, hi}; const bf16x2_t b = __builtin_convertvector(v, bf16x2_t); return __builtin_bit_cast(unsigned, b); }
__device__ __forceinline__ float clamp448(float x) { return fminf(fmaxf(x, -448.0f), 448.0f); }
__device__ __forceinline__ unsigned pk_fp8x4(float a, float b, float c, float d) { int w = 0; w = __builtin_amdgcn_cvt_pk_fp8_f32(clamp448(a), clamp448(b), w, false); w = __builtin_amdgcn_cvt_pk_fp8_f32(clamp448(c), clamp448(d), w, true); return (unsigned)w; }
constexpr int MOE_H3W = 36, MOE_H3 = MOE_H3W * 8 * 9;
constexpr float WSC = 64.0f, HSC = 8.0f, ASC = 4.0f;
__device__ __forceinline__ float bf_lo(unsigned w) { return __uint_as_float(w << 16); }
__device__ __forceinline__ float bf_hi(unsigned w) { return __uint_as_float(w & 0xffff0000u); }
#define DPP_ADD(v, ctrl) (v) += __builtin_bit_cast(float, __builtin_amdgcn_update_dpp(0, __builtin_bit_cast(int, (v)), (ctrl), 0xf, 0xf, false))
__device__ __forceinline__ float wave_sum(float v) {
    DPP_ADD(v, 0xB1); DPP_ADD(v, 0x4E); DPP_ADD(v, 0x141); DPP_ADD(v, 0x140);
    const int vi = __builtin_bit_cast(int, v);
    const float r0 = __builtin_bit_cast(float, __builtin_amdgcn_readlane(vi, 0)), r1 = __builtin_bit_cast(float, __builtin_amdgcn_readlane(vi, 16)), r2 = __builtin_bit_cast(float, __builtin_amdgcn_readlane(vi, 32)), r3 = __builtin_bit_cast(float, __builtin_amdgcn_readlane(vi, 48));
    return (r0 + r1) + (r2 + r3);
}
__device__ __forceinline__ float fast_exp2(float x) { return __builtin_amdgcn_exp2f(x); }
__device__ __forceinline__ float fast_rcp(float x) { return __builtin_amdgcn_rcpf(x); }
__device__ __forceinline__ float silu_f(float x) { return x * fast_rcp(1.0f + fast_exp2(-x * LOG2E)); }
__device__ __forceinline__ float gelu_tanh(float x) { const float z = x * (1.0f + 0.044715f * x * x) * (-2.0f * 0.7978845608028654f * LOG2E); return x * fast_rcp(1.0f + fast_exp2(z)); }

__device__ __forceinline__ int lane_id() { int l; asm volatile("v_mbcnt_lo_u32_b32 %0, -1, 0\n\tv_mbcnt_hi_u32_b32 %0, -1, %0" : "=v"(l)); return l; }
#define TIDX_OF(wv_) ((wv_) * 64 + lane_id())
#define XB_TMO      128
#define XB_XCNT(j)  (256  + 64 * (j))
#define XB_XSUB(j)  (1280 + 64 * (j))
#define XB_XGEN(j)  (2304 + 64 * (j))
#define XB_TOP      3328
#define XB_TOPGEN   3392
#define XCD_BAR_WORDS 3456
#define XB_SPIN_CAP (1u << 18)
__device__ __forceinline__ unsigned xb_ld(unsigned* p)              { return __hip_atomic_load(p, __ATOMIC_RELAXED, __HIP_MEMORY_SCOPE_AGENT); }
__device__ __forceinline__ unsigned xb_add(unsigned* p, unsigned v) { return __hip_atomic_fetch_add(p, v, __ATOMIC_RELAXED, __HIP_MEMORY_SCOPE_AGENT); }
__device__ __forceinline__ unsigned xb_xcc_id() { return (unsigned)__builtin_amdgcn_s_getreg((3 << 11) | 20) & 0xFu; }
#define XB_SPIN(cond, bar) do { unsigned _sp = 0; while (cond) { __builtin_amdgcn_s_sleep(1); \
    if ((++_sp & 255u) == 0u) { if (xb_ld(&(bar)[XB_TMO])) break; if (_sp > XB_SPIN_CAP) { atomicAdd(&(bar)[XB_TMO], 1u); break; } } } } while (0)
struct XcdBarrier { unsigned* bar; unsigned x; volatile LAS unsigned* st; int wv; };
__device__ __forceinline__ XcdBarrier xcd_barrier_post(unsigned* bar, volatile LAS unsigned* st, int wv) {
    XcdBarrier b; b.bar = bar; b.x = xb_xcc_id(); b.st = st; b.wv = wv;
    if (TIDX_OF(wv) == 0) (void)xb_add(&bar[XB_XCNT(b.x)], 1u);
    return b;
}
__device__ __forceinline__ void xcd_barrier_complete(unsigned* bar, unsigned x, unsigned& nloc, unsigned& nx) {
    const unsigned G = gridDim.x * gridDim.y * gridDim.z;
    unsigned sum, cnt, mine, sp = 0u;
    for (;;) {
        sum = 0u; cnt = 0u; mine = 0u;
#pragma unroll
        for (unsigned j = 0; j < 16; ++j) { const unsigned c = xb_ld(&bar[XB_XCNT(j)]); sum += c; cnt += (c > 0u) ? 1u : 0u; mine = (j == x) ? c : mine; }
        if (sum == G) break;
        __builtin_amdgcn_s_sleep(1);
        if ((++sp & 255u) == 0u) { if (xb_ld(&bar[XB_TMO])) break; if (sp > XB_SPIN_CAP) { atomicAdd(&bar[XB_TMO], 1u); break; } }
    }
    nloc = mine > 0u ? mine : 1u; nx = cnt > 0u ? cnt : 1u;
}
__device__ __forceinline__ void xcd_barrier(const XcdBarrier& b) {
    asm volatile("s_waitcnt vmcnt(0)" ::: "memory");
    __syncthreads();
    if (TIDX_OF(b.wv) == 0) {
        unsigned* bar = b.bar;
        __builtin_amdgcn_s_waitcnt(0);
        unsigned nloc = b.st[0], nx = b.st[1];
        if (nloc == 0u) { xcd_barrier_complete(bar, b.x, nloc, nx); b.st[0] = nloc; b.st[1] = nx; }
        const unsigned old = xb_add(&bar[XB_XSUB(b.x)], 1u);
        const unsigned gen = old / nloc;
        if (old + 1u == (gen + 1u) * nloc) {
            __builtin_amdgcn_fence(__ATOMIC_RELEASE, "agent");
            asm volatile("s_waitcnt vmcnt(0)" ::: "memory");
            const unsigned og = xb_add(&bar[XB_TOP], 1u);
            const unsigned tg = og / nx;
            if (og + 1u == (tg + 1u) * nx) xb_add(&bar[XB_TOPGEN], 1u);
            else XB_SPIN(xb_ld(&bar[XB_TOPGEN]) == tg, bar);
            __builtin_amdgcn_fence(__ATOMIC_ACQUIRE, "agent");
            xb_add(&bar[XB_XGEN(b.x)], 1u);
            asm volatile("s_waitcnt vmcnt(0)" ::: "memory");
        } else {
            XB_SPIN(xb_ld(&bar[XB_XGEN(b.x)]) == gen, bar);
            __builtin_amdgcn_fence(__ATOMIC_ACQUIRE, "agent");
            asm volatile("s_waitcnt vmcnt(0)" ::: "memory");
        }
    }
    __syncthreads();
}

namespace pg8 {
constexpr int BM = 256, BK = 64, HALF = 128, HTB = HALF * BK * 2, STAGE_BYTES = 8 * HTB, NXCD = 8, WGM = 8;
__host__ __device__ __forceinline__ int lds_byte(int r, int c) { const int st = (r >> 4) * 2 + (c >> 5), rr = r & 15, cc = c & 31, ob = rr * 64 + cc * 2; return st * 1024 + (ob ^ (((ob >> 9) & 1) << 5)); }
__host__ __device__ __forceinline__ void stage_rc(int b, int& R, int& C) { const int st = b / 1024, sb = b % 1024, swz = sb ^ (((sb >> 9) & 1) << 5); R = (st >> 1) * 16 + swz / 64; C = (st & 1) * 32 + (swz % 64) / 2; }
__host__ __device__ __forceinline__ int perm32(int rho) { const int n = rho >> 4, i = rho & 15; return 8 * (i >> 2) + 4 * n + (i & 3); }

struct Unit { int pm, pn, e, nv, nt; };
__device__ __forceinline__ void static_unit(int L, int nM, int nN, int& pm, int& pn) {
    const int nwg = nM * nN; int wgid = L;
    { const int q = nwg / NXCD, r = nwg % NXCD, xcd = wgid % NXCD, off = wgid / NXCD; wgid = (xcd < r ? xcd * (q + 1) : r * (q + 1) + (xcd - r) * q) + off; }
    const int nig = WGM * nN, gid = wgid / nig, fm = gid * WGM, gsz = (nM - fm) < WGM ? (nM - fm) : WGM;
    pm = fm + ((wgid % nig) % gsz); pn = (wgid % nig) / gsz;
}

template <class Job, bool ALIGN_EPI>
__device__ __forceinline__ void gemm_phase(LAS unsigned char* lds, const Job& J, const int wv) {
    const int tid = TIDX_OF(wv), wid = __builtin_amdgcn_readfirstlane(tid >> 6), lane = tid & 63, wr = wid >> 2, wc = wid & 3, fr = lane & 15, fq = lane >> 4;
    const int KB = J.KB, ntfull = KB / 128;
    unsigned voffA, voffB;
    { int R, C; stage_rc(tid * 16, R, C); const int Rb = Job::PERM ? ((R & ~31) + perm32(R & 31)) : R; voffA = (unsigned)(R * J.ldab + C * 2); voffB = (unsigned)(Rb * KB + C * 2); }
    const size_t kstep = (size_t)(BK * 2);
    const size_t hstepB = (size_t)HALF * KB, qstepB = (size_t)64 * KB, hstepA = (size_t)HALF * J.ldab, qstepA = (size_t)64 * J.ldab;
    const unsigned ldsw = (unsigned)wid * 1024u;
    const int aoff = lds_byte(wr * 64 + fr, fq * 8), boff = lds_byte(wc * 32 + fr, fq * 8);
#define PG8_SA(b, h) (((b) * 2 + (h)) * HTB)
#define PG8_SB(b, h) ((4 + (b) * 2 + (h)) * HTB)
#define PG8_STAGE_X(bufoff, gbase, voff, qstep) do { unsigned _v = (voff), _w = (voff); asm volatile("" : "+v"(_v)); asm volatile("" : "+v"(_w));     \
        const char* _g0 = (const char*)(gbase); const char* _g1 = _g0 + (qstep); asm volatile("" : "+s"(_g1)); \
        __builtin_amdgcn_global_load_lds((const unsigned*)(_g0 + _v), (LAS unsigned*)(lds + (bufoff) + ldsw), 16, 0, 0); \
        __builtin_amdgcn_global_load_lds((const unsigned*)(_g1 + _w), (LAS unsigned*)(lds + (bufoff) + ldsw + 8192), 16, 0, 0); } while (0)
#define PG8_STAGE_B(bufoff, gbase) PG8_STAGE_X(bufoff, gbase, voffB, qstepB)
#define PG8_STAGE_A(bufoff, gbase, h) PG8_STAGE_X(bufoff, (gbase) + (h) * hstepA, voffA, qstepA)
#define PG8_LDA(dst, b, h) do { _Pragma("unroll") for (int m = 0; m < 4; ++m) _Pragma("unroll") for (int k = 0; k < 2; ++k) dst[m][k] = *(const LAS bf16x8*)(lds + PG8_SA(b, h) + aoff + m * 2048 + k * 1024); } while (0)
#define PG8_LDB(dst, b, h) do { _Pragma("unroll") for (int n = 0; n < 2; ++n) _Pragma("unroll") for (int k = 0; k < 2; ++k) dst[n][k] = *(const LAS bf16x8*)(lds + PG8_SB(b, h) + boff + n * 2048 + k * 1024); } while (0)
#define PG8_CAT(x) __builtin_shufflevector(__builtin_bit_cast(i32x4, (x)[0]), __builtin_bit_cast(i32x4, (x)[1]), 0, 1, 2, 3, 4, 5, 6, 7)
#define PG8_MMA(ai, bj, At, Bt) do { __builtin_amdgcn_s_setprio(1); if constexpr (Job::FP8) { _Pragma("unroll") for (int m = 0; m < 4; ++m) _Pragma("unroll") for (int n = 0; n < 2; ++n) \
        acc[ai][bj][m][n] = __builtin_amdgcn_mfma_scale_f32_16x16x128_f8f6f4(PG8_CAT(Bt[n]), PG8_CAT(At[m]), acc[ai][bj][m][n], 0, 0, 0, 0, 0, 0); } else { \
        _Pragma("unroll") for (int m = 0; m < 4; ++m) _Pragma("unroll") for (int n = 0; n < 2; ++n) _Pragma("unroll") for (int k = 0; k < 2; ++k) \
        acc[ai][bj][m][n] = __builtin_amdgcn_mfma_f32_16x16x32_bf16(Bt[n][k], At[m][k], acc[ai][bj][m][n], 0, 0, 0); } __builtin_amdgcn_s_setprio(0); } while (0)
#define PG8_WAIT_V(n) asm volatile("s_waitcnt vmcnt(" #n ")" ::: "memory")
#define PG8_WAIT_L(n) asm volatile("s_waitcnt lgkmcnt(" #n ")" ::: "memory")
#define PG8_BAR __builtin_amdgcn_s_barrier()
#define PG8_SCHED __builtin_amdgcn_sched_barrier(0)
    Unit cur, nxt; int ui = 0; cur.nt = 0; nxt.nt = 0;
    if (!J.next(0, cur)) return;
    int nt = cur.nt ? cur.nt : ntfull;
    f32x4 acc[2][2][4][2];
#pragma unroll
    for (int a = 0; a < 2; ++a)
#pragma unroll
        for (int b = 0; b < 2; ++b)
#pragma unroll
            for (int m = 0; m < 4; ++m)
#pragma unroll
                for (int n = 0; n < 2; ++n) acc[a][b][m][n] = (f32x4){0.f, 0.f, 0.f, 0.f};
    bf16x8 At[4][2], B0[2][2], B1[2][2];
    const char* cA = J.a_ptr(cur); const char* cB = J.b_ptr(cur);
    PG8_STAGE_B(PG8_SB(0, 0), cB); PG8_STAGE_B(PG8_SB(0, 1), cB + hstepB); PG8_STAGE_A(PG8_SA(0, 0), cA, 0); PG8_STAGE_A(PG8_SA(0, 1), cA, 1);
    if (wr == 1) PG8_BAR;
    PG8_WAIT_V(2); PG8_BAR;
    PG8_STAGE_B(PG8_SB(1, 0), cB + kstep); PG8_STAGE_A(PG8_SA(1, 0), cA + kstep, 0); PG8_STAGE_B(PG8_SB(1, 1), cB + hstepB + kstep);
    PG8_WAIT_V(6); PG8_BAR;
    for (;;) {
        nxt.nt = 0; const bool has_next = J.next(ui + 1, nxt);
        const char* nA = cA; const char* nB = cB;
        if (has_next) { nA = J.a_ptr(nxt); nB = J.b_ptr(nxt); }
        for (int t = 0; t < nt; t += 2) {
            const bool last = (t == nt - 2);
            const char* a1 = cA + (size_t)(t + 1) * kstep;
            const char* a2 = last ? nA : cA + (size_t)(t + 2) * kstep; const char* b2 = last ? nB : cB + (size_t)(t + 2) * kstep;
            const char* a3 = a2 + kstep; const char* b3 = b2 + kstep;
            PG8_LDB(B0, 0, 0); PG8_LDB(B1, 0, 1); PG8_SCHED; PG8_LDA(At, 0, 0); PG8_STAGE_A(PG8_SA(1, 1), a1, 1);
            PG8_WAIT_V(8); PG8_WAIT_L(0); PG8_BAR; PG8_MMA(0, 0, At, B0); PG8_MMA(0, 1, At, B1); PG8_BAR; PG8_SCHED;
            PG8_LDA(At, 0, 1); PG8_STAGE_B(PG8_SB(0, 0), b2); PG8_STAGE_B(PG8_SB(0, 1), b2 + hstepB); PG8_STAGE_A(PG8_SA(0, 0), a2, 0);
            PG8_WAIT_V(8); PG8_WAIT_L(0); PG8_BAR; PG8_MMA(1, 0, At, B0); PG8_MMA(1, 1, At, B1); PG8_BAR; PG8_SCHED;
            PG8_LDB(B0, 1, 0); PG8_LDB(B1, 1, 1); PG8_SCHED; PG8_LDA(At, 1, 0); PG8_STAGE_A(PG8_SA(0, 1), a2, 1);
            PG8_WAIT_V(8); PG8_WAIT_L(0); PG8_BAR; PG8_MMA(0, 0, At, B0); PG8_MMA(0, 1, At, B1); PG8_BAR; PG8_SCHED;
            PG8_LDA(At, 1, 1); PG8_STAGE_B(PG8_SB(1, 0), b3); PG8_STAGE_B(PG8_SB(1, 1), b3 + hstepB); PG8_STAGE_A(PG8_SA(1, 0), a3, 0);
            PG8_WAIT_V(8); PG8_WAIT_L(0); PG8_BAR; PG8_MMA(1, 0, At, B0); PG8_MMA(1, 1, At, B1); PG8_BAR; PG8_SCHED;
        }
        if constexpr (ALIGN_EPI) { if (wr == 0) PG8_BAR; }
        { int l2 = lane_id(); asm volatile("" : "+v"(l2));
          J.epi(acc, cur, wr, wc, l2 & 15, l2 >> 4); }
        if (!has_next) break;
#pragma unroll
        for (int a = 0; a < 2; ++a)
#pragma unroll
            for (int b = 0; b < 2; ++b)
#pragma unroll
                for (int m = 0; m < 4; ++m)
#pragma unroll
                    for (int n = 0; n < 2; ++n) acc[a][b][m][n] = (f32x4){0.f, 0.f, 0.f, 0.f};
        cur = nxt; cA = nA; cB = nB; ++ui; nt = cur.nt ? cur.nt : ntfull;
        if constexpr (ALIGN_EPI) { if (wr == 1) PG8_BAR; }
    }
    PG8_WAIT_V(0);
    if constexpr (!ALIGN_EPI) { if (wr == 0) PG8_BAR; }
    PG8_BAR;
#undef PG8_SA
#undef PG8_SB
#undef PG8_STAGE_A
#undef PG8_STAGE_B
#undef PG8_STAGE_X
#undef PG8_LDA
#undef PG8_LDB
#undef PG8_MMA
#undef PG8_CAT
#undef PG8_WAIT_V
#undef PG8_WAIT_L
#undef PG8_BAR
#undef PG8_SCHED
}
}
using pg8::Unit;

__device__ __forceinline__ f32x4 swiglu4(f32x4 g, f32x4 u, float c1, float c2) {
    const f32x4 t = g * c1; f32x4 e = (f32x4){fast_exp2(t[0]), fast_exp2(t[1]), fast_exp2(t[2]), fast_exp2(t[3])}; e = e + 1.0f;
    const f32x4 r = (f32x4){fast_rcp(e[0]), fast_rcp(e[1]), fast_rcp(e[2]), fast_rcp(e[3])};
    return ((g * u) * r) * c2;
}
__device__ __forceinline__ void st_bf4(bf16_t* p, f32x4 v) { u32x2 w; w.x = cvt_pk_bf16(v[0], v[1]); w.y = cvt_pk_bf16(v[2], v[3]); *(u32x2*)p = w; }
__device__ __forceinline__ void st_f8x8(unsigned char* p, f32x4 v0, f32x4 v1) { u32x2 w; w.x = pk_fp8x4(v0[0], v0[1], v0[2], v0[3]); w.y = pk_fp8x4(v1[0], v1[1], v1[2], v1[3]); *(u32x2*)p = w; }
__device__ __forceinline__ void st_bf8(bf16_t* p, f32x4 v0, f32x4 v1) { u32x4 w; w.x = cvt_pk_bf16(v0[0], v0[1]); w.y = cvt_pk_bf16(v0[2], v0[3]); w.z = cvt_pk_bf16(v1[0], v1[1]); w.w = cvt_pk_bf16(v1[2], v1[3]); *(u32x4*)p = w; }


struct JobProj {
    static constexpr bool PERM = false, FP8 = false;
    int KB, ldab, G, c, NT = 0; const bf16_t *H, *WT; bf16_t *PROJ, *KVC; const float* rope; float* ssq;
    __device__ __forceinline__ bool next(int i, Unit& u) const {
        const int L = i * G + c;
        if (L < 448) { pg8::static_unit(L, 64, 7, u.pm, u.pn); u.e = 0; u.nv = 256; return true; }
        if (L < 452) { u.pm = L - 448; u.pn = 2; u.e = 1; u.nv = 256; return true; }
        return false;
    }
    __device__ __forceinline__ const char* a_ptr(const Unit& u) const { return (const char*)H + (ptrdiff_t)u.e * ((ptrdiff_t)WS_HC - (ptrdiff_t)WS_H) + (size_t)u.pm * 256 * DM * 2; }
    __device__ __forceinline__ const char* b_ptr(const Unit& u) const { return (const char*)WT + (size_t)u.pn * 256 * DM * 2; }
    __device__ __forceinline__ void epi(const f32x4 (&acc)[2][2][4][2], const Unit& u, int wr, int wc, int fr, int fq) const {
        const int row0 = u.pm * 256 + wr * 64 + fr;
        if (u.e == 1) {
#pragma unroll
            for (int ai = 0; ai < 2; ++ai)
#pragma unroll
                for (int m = 0; m < 4; ++m) { bf16_t* rp = KVC + (size_t)(row0 + ai * 128 + m * 16) * 256 + wc * 32 + 4 * fq;
#pragma unroll
                    for (int bj = 0; bj < 2; ++bj)
#pragma unroll
                        for (int n = 0; n < 2; ++n) st_bf4(rp + bj * 128 + n * 16, acc[ai][bj][m][n]); }
        } else if (u.pn <= 2) {
            const float qs = u.pn < 2 ? QSCALE : 1.0f;
#pragma unroll
            for (int ai = 0; ai < 2; ++ai)
#pragma unroll
                for (int m = 0; m < 4; ++m) { const int row = row0 + ai * 128 + m * 16, t = row & (SEQ - 1), pos = (wc & 1) ? (t & 63) : (t >> 6);
                    const f32x4 cs0 = *(const f32x4*)(rope + (pos * 16 + 4 * fq) * 2), cs1 = *(const f32x4*)(rope + (pos * 16 + 4 * fq) * 2 + 4);
                    const f32x4 cv = (f32x4){cs0[0], cs0[2], cs1[0], cs1[2]}, sv = (f32x4){cs0[1], cs0[3], cs1[1], cs1[3]};
                    bf16_t* rp = PROJ + (size_t)row * INW + u.pn * 256 + wc * 32 + 4 * fq;
#pragma unroll
                    for (int bj = 0; bj < 2; ++bj) { const f32x4 v1 = acc[ai][bj][m][0], v2 = acc[ai][bj][m][1]; f32x4 o1, o2;
                        if (u.pn < 2 || bj == 0) { o1 = (v1 * cv - v2 * sv) * qs; o2 = (v2 * cv + v1 * sv) * qs; } else { o1 = v1; o2 = v2; }
                        st_bf4(rp + bj * 128, o1); st_bf4(rp + bj * 128 + 16, o2); } }
        } else {
#pragma unroll
            for (int ai = 0; ai < 2; ++ai)
#pragma unroll
                for (int m = 0; m < 4; ++m) { const int row = row0 + ai * 128 + m * 16; bf16_t* rp = PROJ + (size_t)row * INW + u.pn * 256 + wc * 32 + 4 * fq; float ss = 0.f;
#pragma unroll
                    for (int bj = 0; bj < 2; ++bj)
#pragma unroll
                        for (int n = 0; n < 2; ++n) { const f32x4 v = acc[ai][bj][m][n]; const f32x4 ge = (f32x4){gelu_tanh(v[0]), gelu_tanh(v[1]), gelu_tanh(v[2]), gelu_tanh(v[3])};
                            ss += (ge[0] * ge[0] + ge[1] * ge[1]) + (ge[2] * ge[2] + ge[3] * ge[3]); st_bf4(rp + bj * 128 + n * 16, ge); }
                    if (u.pn >= 5) { ss += __shfl_xor(ss, 16); ss += __shfl_xor(ss, 32); if (fq == 0) ssq[(size_t)row * 8 + (u.pn - 5) * 4 + wc] = ss; } }
        }
    }
};

template <bool F8, bool XF32> struct JobRes {
    static constexpr bool PERM = true, FP8 = F8;
    int KB, ldab, G, c, pool, NT = 0; float ascale; const void *A, *Bt; const void* xin; bf16_t* xout; const float* gate; const float* cscale; float* ssq2;
    __device__ __forceinline__ bool next(int i, Unit& u) const { const int L = i * G + c; if (L >= 256) return false; pg8::static_unit(L, 64, 4, u.pm, u.pn); u.e = 0; u.nv = 256; return true; }
    __device__ __forceinline__ const char* a_ptr(const Unit& u) const { return (const char*)A + (size_t)u.pm * 256 * ldab + (pool ? u.pn * 512 : 0); }
    __device__ __forceinline__ const char* b_ptr(const Unit& u) const { return (const char*)Bt + (size_t)u.pn * 256 * KB; }
    __device__ __forceinline__ void epi(const f32x4 (&acc)[2][2][4][2], const Unit& u, int wr, int wc, int fr, int fq) const {
        const int b = u.pm >> 4, col0 = u.pn * 256 + wc * 32 + 8 * fq; const float* g = gate + (size_t)b * 6144 + col0;
        f32x4 gv[2][2];
#pragma unroll
        for (int bj = 0; bj < 2; ++bj)
#pragma unroll
            for (int n = 0; n < 2; ++n) { gv[bj][n] = *(const f32x4*)(g + bj * 128 + n * 4) * ascale; if (cscale) gv[bj][n] = gv[bj][n] * *(const f32x4*)(cscale + col0 + bj * 128 + n * 4); }
#pragma unroll
        for (int ai = 0; ai < 2; ++ai)
#pragma unroll
            for (int m = 0; m < 4; ++m) { const int row = u.pm * 256 + ai * 128 + wr * 64 + m * 16 + fr; const size_t off = (size_t)row * DM + col0; float ss = 0.f;
#pragma unroll
                for (int bj = 0; bj < 2; ++bj) { f32x4 x0, x1;
                    if constexpr (XF32) { x0 = *(const f32x4*)((const float*)xin + off + bj * 128); x1 = *(const f32x4*)((const float*)xin + off + bj * 128 + 4); }
                    else { const u32x4 w = *(const u32x4*)((const bf16_t*)xin + off + bj * 128); x0 = (f32x4){bf_lo(w.x), bf_hi(w.x), bf_lo(w.y), bf_hi(w.y)}; x1 = (f32x4){bf_lo(w.z), bf_hi(w.z), bf_lo(w.w), bf_hi(w.w)}; }
                    const f32x4 o0 = x0 + gv[bj][0] * acc[ai][bj][m][0], o1 = x1 + gv[bj][1] * acc[ai][bj][m][1];
                    st_bf8(xout + off + bj * 128, o0, o1);
                    ss += ((o0[0] * o0[0] + o0[1] * o0[1]) + (o0[2] * o0[2] + o0[3] * o0[3])) + ((o1[0] * o1[0] + o1[1] * o1[1]) + (o1[2] * o1[2] + o1[3] * o1[3])); }
                if (ssq2) ssq2[(size_t)row * 64 + u.pn * 16 + wc * 4 + fq] = ss; }
    }
};

struct JobGU {
    static constexpr bool PERM = true, FP8 = false;
    int KB, ldab, G, c, NT = 0; const bf16_t *H, *WT; unsigned char* ACT;
    __device__ __forceinline__ bool next(int i, Unit& u) const { const int L = i * G + c; if (L >= 64 * 22) return false; pg8::static_unit(L, 64, 22, u.pm, u.pn); u.e = 0; u.nv = 256; return true; }
    __device__ __forceinline__ const char* a_ptr(const Unit& u) const { return (const char*)H + (size_t)u.pm * 256 * DM * 2; }
    __device__ __forceinline__ const char* b_ptr(const Unit& u) const { return (const char*)WT + (size_t)u.pn * 256 * DM * 2; }
    __device__ __forceinline__ void epi(const f32x4 (&acc)[2][2][4][2], const Unit& u, int wr, int wc, int fr, int fq) const {
#pragma unroll
        for (int ai = 0; ai < 2; ++ai)
#pragma unroll
            for (int m = 0; m < 4; ++m) { unsigned char* rp = ACT + (size_t)(u.pm * 256 + ai * 128 + wr * 64 + m * 16 + fr) * FFD + u.pn * 128 + wc * 32 + 8 * fq;
                f32x4 o[2];
#pragma unroll
                for (int n = 0; n < 2; ++n) o[n] = swiglu4(acc[ai][0][m][n], acc[ai][1][m][n], -LOG2E, ASC);
                st_f8x8(rp, o[0], o[1]); asm volatile("" ::: "memory"); }
    }
};

struct MoeTiles {
    int p1, p2, p3, p4, p5, p6, p7, p8;
    __device__ __forceinline__ void init(const int* tot) {
        int s = 0;
#define MT_STEP(k, dst) s += ((int)__builtin_amdgcn_readfirstlane(tot[k]) + 255) >> 8; dst = s;
        MT_STEP(0, p1) MT_STEP(1, p2) MT_STEP(2, p3) MT_STEP(3, p4) MT_STEP(4, p5) MT_STEP(5, p6) MT_STEP(6, p7) MT_STEP(7, p8)
#undef MT_STEP
    }
    __device__ __forceinline__ int expert_of(int rt) const { int e = 0; e = rt >= p1 ? 1 : e; e = rt >= p2 ? 2 : e; e = rt >= p3 ? 3 : e; e = rt >= p4 ? 4 : e; e = rt >= p5 ? 5 : e; e = rt >= p6 ? 6 : e; e = rt >= p7 ? 7 : e; return __builtin_amdgcn_readfirstlane(e); }
};
__device__ __forceinline__ int moe_gu_groups(int ntiles, int G) { if (G != 256) return G; const int units = ntiles * 28, rounds = (units + 255) >> 8; if (rounds == 0) return G; int gp = (units + rounds - 1) / rounds; gp = gp < 247 ? 247 : gp; return gp > G ? G : gp; }
__device__ __forceinline__ int moe_h3_quota(int nh) { const int q = MOE_H3W * 8 * nh; return q > MOE_H3 ? MOE_H3 : q; }
__device__ __forceinline__ int moe_nsplit(int ntiles, int G) { const int n = (G == 256 && ntiles > 128) ? ntiles - 128 : 0; return n > 8 ? 8 : n; }
struct JobMGU {
    static constexpr bool PERM = true, FP8 = true;
    int KB, ldab, G, c, NT = 0; MoeTiles T; const unsigned char *XS, *WT; unsigned char* ACT;
    __device__ __forceinline__ bool next(int i, Unit& u) const { const int L = i * G + c; if (L >= T.p8 * 28) return false; pg8::static_unit(L, T.p8, 28, u.pm, u.pn); u.e = T.expert_of(u.pm); u.nv = 256; return true; }
    __device__ __forceinline__ const char* a_ptr(const Unit& u) const { return (const char*)XS + (size_t)u.pm * 256 * DM; }
    __device__ __forceinline__ const char* b_ptr(const Unit& u) const { return (const char*)WT + ((size_t)u.e * 7168 + (size_t)u.pn * 256) * DM; }
    __device__ __forceinline__ void epi(const f32x4 (&acc)[2][2][4][2], const Unit& u, int wr, int wc, int fr, int fq) const {
#pragma unroll
        for (int ai = 0; ai < 2; ++ai)
#pragma unroll
            for (int m = 0; m < 4; ++m) { unsigned char* rp = ACT + (size_t)(u.pm * 256 + ai * 128 + wr * 64 + m * 16 + fr) * FFE + u.pn * 128 + wc * 32 + 8 * fq;
                f32x4 o[2];
#pragma unroll
                for (int n = 0; n < 2; ++n) o[n] = swiglu4(acc[ai][0][m][n], acc[ai][1][m][n], -LOG2E / (WSC * HSC), ASC / ((WSC * HSC) * (WSC * HSC)));
                st_f8x8(rp, o[0], o[1]); asm volatile("" ::: "memory"); }
    }
};
struct JobMDown {
    static constexpr bool PERM = true, FP8 = true;
    int KB, ldab, G, c, NT = 0; MoeTiles T; const unsigned char *ACT, *WT; bf16_t *Y, *YS;
    int nfull, nsplit;
    __device__ __forceinline__ bool next(int i, Unit& u) const { const int L = i * G + c, nf = nfull * 4;
        if (L < nf) { pg8::static_unit(L, nfull, 4, u.pm, u.pn); u.nv = -1; u.nt = 0; }
        else { const int Ls = L - nf; if (Ls >= nsplit * 28) return false; const int q = Ls / 7; u.nv = Ls - q * 7; u.pn = q & 3; u.pm = nfull + (q >> 2); u.nt = 4; }
        u.e = T.expert_of(u.pm); return true; }
    __device__ __forceinline__ const char* a_ptr(const Unit& u) const { return (const char*)ACT + (size_t)u.pm * 256 * FFE + (u.nv < 0 ? 0 : u.nv * 512); }
    __device__ __forceinline__ const char* b_ptr(const Unit& u) const { return (const char*)WT + ((size_t)u.e * DM + (size_t)u.pn * 256) * FFE + (u.nv < 0 ? 0 : u.nv * 512); }
    __device__ __forceinline__ void epi(const f32x4 (&acc)[2][2][4][2], const Unit& u, int wr, int wc, int fr, int fq) const {
        bf16_t* base = (bf16_t*)((char*)Y + (u.nv < 0 ? (ptrdiff_t)0 : (ptrdiff_t)((char*)YS - (char*)Y))) + (u.nv < 0 ? (size_t)u.pm : (size_t)u.nv * 8 + (u.pm - nfull)) * 256 * DM;
#pragma unroll
        for (int ai = 0; ai < 2; ++ai)
#pragma unroll
            for (int m = 0; m < 4; ++m) { bf16_t* rp = base + (size_t)(ai * 128 + wr * 64 + m * 16 + fr) * DM + u.pn * 256 + wc * 32 + 8 * fq;
#pragma unroll
                for (int bj = 0; bj < 2; ++bj) st_bf8(rp + bj * 128, acc[ai][bj][m][0] * (1.0f / (WSC * ASC)), acc[ai][bj][m][1] * (1.0f / (WSC * ASC))); asm volatile("" ::: "memory"); }
    }
};

struct Args { const float* in[22]; float* out; unsigned char* ws; int ph_lo, ph_hi; int wv, pad; };
enum { I_X = 0, I_C, I_CTX, I_CCTX, I_WADA, I_BADA, I_WIN, I_SINK, I_GMGAIN, I_GMWS, I_GMBS, I_WOUT, I_FG, I_FU, I_FD, I_PW, I_PSC, I_RW, I_MG, I_MU, I_MD, I_FGAIN };

__device__ __forceinline__ void tr_item(const float* W, int K, int N, bf16_t* WT, int mode, int item, LAS float* scr, int lane) {
    const int nblk = N >> 5, kb = item / nblk, nb = item - kb * nblk, k0 = kb * 64, n0 = nb * 32;
    const int drow0 = mode == 0 ? n0 : (((n0 >> 7) << 8) + (n0 & 127) + (mode == 2 ? 128 : 0));
    float ld[32];
#pragma unroll
    for (int i = 0; i < 32; ++i) ld[i] = W[(size_t)(k0 + 2 * i + (lane >> 5)) * N + n0 + (lane & 31)];
#pragma unroll
    for (int i = 0; i < 32; ++i) scr[(2 * i + (lane >> 5)) * 33 + (lane & 31)] = ld[i];
    LDS_WAIT();
    const int c = lane & 7;
#pragma unroll
    for (int j = 0; j < 4; ++j) { const int n = (lane >> 3) + 8 * j; const LAS float* s = scr + (8 * c) * 33 + n;
        u32x4 o; o.x = cvt_pk_bf16(s[0 * 33], s[1 * 33]); o.y = cvt_pk_bf16(s[2 * 33], s[3 * 33]); o.z = cvt_pk_bf16(s[4 * 33], s[5 * 33]); o.w = cvt_pk_bf16(s[6 * 33], s[7 * 33]);
        *(u32x4*)(WT + (size_t)(drow0 + n) * K + k0 + 8 * c) = o; }
    LDS_WAIT();
}
__device__ __forceinline__ void tr_item8(const float* W, int K, int N, unsigned char* WT, int mode, int item, LAS float* scr, int lane) {
    const int nblk = N >> 5, kb = item / nblk, nb = item - kb * nblk, k0 = kb * 128, n0 = nb * 32;
    const int drow0 = mode == 0 ? n0 : (((n0 >> 7) << 8) + (n0 & 127) + (mode == 2 ? 128 : 0));
#pragma unroll
    for (int hb = 0; hb < 2; ++hb) { float ld[32];
#pragma unroll
        for (int i = 0; i < 32; ++i) ld[i] = W[(size_t)(k0 + 64 * hb + 2 * i + (lane >> 5)) * N + n0 + (lane & 31)];
#pragma unroll
        for (int i = 0; i < 32; ++i) scr[(64 * hb + 2 * i + (lane >> 5)) * 33 + (lane & 31)] = ld[i]; }
    LDS_WAIT();
    const int c = lane & 15;
#pragma unroll
    for (int j = 0; j < 8; ++j) { const int n = (lane >> 4) + 4 * j; const LAS float* s = scr + (8 * c) * 33 + n;
        u32x2 o; o.x = pk_fp8x4(s[0 * 33] * WSC, s[1 * 33] * WSC, s[2 * 33] * WSC, s[3 * 33] * WSC); o.y = pk_fp8x4(s[4 * 33] * WSC, s[5 * 33] * WSC, s[6 * 33] * WSC, s[7 * 33] * WSC);
        *(u32x2*)(WT + (size_t)(drow0 + n) * K + k0 + 8 * c) = o; }
    LDS_WAIT();
}
__device__ __forceinline__ void ada_task(const float* c, const float* cctx, const float* w_ada, float* part, int task, int lane) {
    const int l = task / 768, rem = task - l * 768, cb = rem >> 5, kc = rem & 31;
    const int kk = kc * 32 + (lane & 31);
    float sv[5];
#pragma unroll
    for (int b = 0; b < 4; ++b) { const float v = c[b * DM + kk]; sv[b] = v / (1.0f + __expf(-v)); }
    { const float v = cctx[kk]; sv[4] = v / (1.0f + __expf(-v)); }
    const float* wp = w_ada + ((size_t)l * DM + kc * 32) * 6144 + cb * 256 + lane * 4;
    f32x4 acc[5];
#pragma unroll
    for (int b = 0; b < 5; ++b) acc[b] = (f32x4){0.f, 0.f, 0.f, 0.f};
#pragma unroll
    for (int k = 0; k < 32; ++k) { const f32x4 w = *(const f32x4*)(wp + (size_t)k * 6144);
#pragma unroll
        for (int b = 0; b < 5; ++b) { const float s = __shfl(sv[b], k); acc[b] = acc[b] + w * s; } }
#pragma unroll
    for (int b = 0; b < 5; ++b) *(f32x4*)(part + (((size_t)(l * 32 + kc) * 5 + b) * 6144 + cb * 256 + lane * 4)) = acc[b];
}
constexpr int MOE_I = 8 * 112, NMOE = 8 * 3 * MOE_I;
struct TrDesc { const float* src; unsigned char* dst; int N, K; };
__device__ __forceinline__ TrDesc moe_desc(const Args& a, int m) {
    unsigned char* ws = a.ws; const float* W; unsigned char* WT; int K, N, mode, q;
    if (m < 16 * MOE_I) { const int e = m / (2 * MOE_I); q = m - e * (2 * MOE_I); WT = ws + WS_WMGU + (size_t)e * 7168 * DM; K = DM; N = FFE;
        if (q < MOE_I) { W = a.in[I_MG] + (size_t)e * DM * FFE; mode = 1; } else { q -= MOE_I; W = a.in[I_MU] + (size_t)e * DM * FFE; mode = 2; } }
    else { const int md = m - 16 * MOE_I, e = md / MOE_I; q = md - e * MOE_I; W = a.in[I_MD] + (size_t)e * FFE * DM; WT = ws + WS_WMDN + (size_t)e * DM * FFE; K = FFE; N = DM; mode = 0; }
    const int nblk = N >> 5, kb = q / nblk, nb = q - kb * nblk, k0 = kb * 128, n0 = nb * 32;
    const int drow0 = mode == 0 ? n0 : (((n0 >> 7) << 8) + (n0 & 127) + (mode == 2 ? 128 : 0));
    TrDesc d; d.src = W + (size_t)k0 * N + n0; d.dst = WT + (size_t)drow0 * K + k0; d.N = N; d.K = K; return d;
}
__device__ __forceinline__ void tr8_load(const TrDesc& d, int hb, float (&ld)[32], int lane) {
    const float* p = d.src + (size_t)(64 * hb + (lane >> 5)) * d.N + (lane & 31);
#pragma unroll
    for (int i = 0; i < 32; ++i) ld[i] = __builtin_nontemporal_load(p + (size_t)(2 * i) * d.N);
}
__device__ __forceinline__ void tr8_tolds(int hb, const float (&ld)[32], LAS float* scr, int lane) {
#pragma unroll
    for (int i = 0; i < 32; ++i) scr[(64 * hb + 2 * i + (lane >> 5)) * 33 + (lane & 31)] = ld[i];
}
__device__ __forceinline__ void tr8_out(const TrDesc& d, LAS float* scr, int lane) {
    LDS_WAIT();
    const int c = lane & 15;
#pragma unroll
    for (int j = 0; j < 8; ++j) { const int n = (lane >> 4) + 4 * j; const LAS float* s = scr + (8 * c) * 33 + n;
        u32x2 o; o.x = pk_fp8x4(s[0 * 33] * WSC, s[1 * 33] * WSC, s[2 * 33] * WSC, s[3 * 33] * WSC); o.y = pk_fp8x4(s[4 * 33] * WSC, s[5 * 33] * WSC, s[6 * 33] * WSC, s[7 * 33] * WSC);
        *(u32x2*)(d.dst + (size_t)n * d.K + 8 * c) = o; }
    LDS_WAIT();
}
__device__ __forceinline__ void moe_stream(const Args& a, LAS float* scr, int m0, int hi, int stride, int lane) {
    if (m0 >= hi) return;
    float la[32], lb[32];
    TrDesc d = moe_desc(a, m0); tr8_load(d, 0, la, lane); tr8_load(d, 1, lb, lane);
    for (int m = m0; m < hi; m += stride) {
        const bool hn = m + stride < hi; TrDesc dn = d; if (hn) dn = moe_desc(a, m + stride);
        tr8_tolds(0, la, scr, lane); if (hn) tr8_load(dn, 0, la, lane);
        tr8_tolds(1, lb, scr, lane); if (hn) tr8_load(dn, 1, lb, lane);
        tr8_out(d, scr, lane);
        d = dn;
    }
}
__device__ __forceinline__ void moe_convert_range(const Args& a, LAS unsigned char* lds, int lo, int hi, int hc, int nh) {
    const int lane = lane_id(), wave = a.wv;
    moe_stream(a, (LAS float*)(lds + wave * 16896), lo + hc * 8 + wave, hi, nh * 8, lane);
}
constexpr int GP_PROJ = 226, GP_GU = 235;
constexpr int MOE_H1 = 10 * 8 * (256 - GP_PROJ), MOE_H2 = 32 * 8 * (256 - GP_GU);
constexpr int MOE_X0 = NMOE - MOE_H1 - MOE_H2 - MOE_H3, MOE_X1 = MOE_X0 + MOE_H1, MOE_X2 = MOE_X1 + MOE_H2;
__device__ __forceinline__ void p0_prologue(const Args& a, LAS unsigned char* lds, int G) {
    const int tid = TIDX_OF(a.wv), lane = tid & 63, wave = a.wv;
    LAS float* scr = (LAS float*)(lds + wave * 16896);
    const int gw = blockIdx.x * 8 + wave, NGW = G * 8;
    unsigned char* ws = a.ws;
    for (int idx = blockIdx.x * 512 + tid; idx < 1024; idx += G * 512) { const int pos = idx >> 4, i = idx & 15;
        const float inv = exp2f(-(float)i * (13.287712379549449f / 16.0f));
        const float ang = (float)pos * inv; float sn, cs; sn = sinf(ang); cs = cosf(ang);
        ((float*)(ws + WS_ROPE))[idx * 2] = cs; ((float*)(ws + WS_ROPE))[idx * 2 + 1] = sn; }
    constexpr int N_ADA = 1536;
    constexpr int I_IN = 16 * 56, I_OUT = 16 * 32, I_F = 16 * 88, I_FDN = 22 * 32, I_PWI = 4 * 32;
    constexpr int NITEMS = N_ADA + I_IN + I_OUT + 2 * I_F + I_FDN + I_PWI;
    for (int it = gw; it < NITEMS; it += NGW) {
        int r = it;
        if (r < N_ADA) { ada_task(a.in[I_C], a.in[I_CCTX], a.in[I_WADA], (float*)(ws + WS_PART), r, lane); continue; } r -= N_ADA;
        if (r < I_IN) { tr_item(a.in[I_WIN], DM, INW, (bf16_t*)(ws + WS_WIN), 0, r, scr, lane); continue; } r -= I_IN;
        if (r < I_OUT) { tr_item(a.in[I_WOUT], DM, DM, (bf16_t*)(ws + WS_WOUT), 0, r, scr, lane); continue; } r -= I_OUT;
        if (r < I_F) { tr_item(a.in[I_FG], DM, FFD, (bf16_t*)(ws + WS_WGU), 1, r, scr, lane); continue; } r -= I_F;
        if (r < I_F) { tr_item(a.in[I_FU], DM, FFD, (bf16_t*)(ws + WS_WGU), 2, r, scr, lane); continue; } r -= I_F;
        if (r < I_FDN) { tr_item8(a.in[I_FD], FFD, DM, ws + WS_WDN, 0, r, scr, lane); continue; } r -= I_FDN;
        tr_item(a.in[I_PW] + (size_t)(r >> 5) * 65536, 256, 256, (bf16_t*)(ws + WS_WPOOL) + (size_t)(r >> 5) * 65536, 0, r & 31, scr, lane);
    }
    { const int x0 = G == 256 ? MOE_X0 : NMOE; moe_stream(a, scr, (gw + NGW - (NITEMS % NGW)) % NGW, x0, NGW, lane); }
}
__device__ __forceinline__ void p0b_modreduce(const Args& a, int G) {
    const float* part = (const float*)(a.ws + WS_PART); float* mod = (float*)(a.ws + WS_MOD);
    for (int idx = blockIdx.x * 512 + TIDX_OF(a.wv); idx < 2 * 5 * 1536; idx += G * 512) {
        const int l = idx / 7680, r = idx - l * 7680, b = r / 1536, j4 = r - b * 1536;
        f32x4 s = *(const f32x4*)(a.in[I_BADA] + l * 6144 + j4 * 4);
        f32x4 pv[32];
#pragma unroll
        for (int kc = 0; kc < 32; ++kc) pv[kc] = *(const f32x4*)(part + (((size_t)(l * 32 + kc) * 5 + b) * 6144 + j4 * 4));
#pragma unroll
        for (int kc = 0; kc < 32; ++kc) s = s + pv[kc];
        *(f32x4*)(mod + (size_t)(l * 5 + b) * 6144 + j4 * 4) = s;
    }
}

__device__ __forceinline__ void mod_row(const float* xrow, const float* shift, const float* scale, bf16_t* orow, int lane) {
    const f32x4* xr = (const f32x4*)xrow + lane; f32x4 v[4]; float ss = 0.f;
#pragma unroll
    for (int j = 0; j < 4; ++j) { v[j] = xr[64 * j]; ss += (v[j][0] * v[j][0] + v[j][1] * v[j][1]) + (v[j][2] * v[j][2] + v[j][3] * v[j][3]); }
    const float rstd = rsqrtf(wave_sum(ss) * (1.0f / DM) + EPS);
#pragma unroll
    for (int j = 0; j < 4; ++j) { const f32x4 sh = ((const f32x4*)shift)[lane + 64 * j], sc = ((const f32x4*)scale)[lane + 64 * j];
        st_bf4(orow + (lane + 64 * j) * 4, v[j] * rstd * (sc + 1.0f) + sh); }
}
__device__ __forceinline__ f32x2 ld_bf2(const bf16_t* p) { const unsigned w = *(const unsigned*)p; return (f32x2){bf_lo(w), bf_hi(w)}; }
__device__ __forceinline__ f32x4 ld_bf4(const bf16_t* p) { const u32x2 w = *(const u32x2*)p; return (f32x4){bf_lo(w.x), bf_hi(w.x), bf_lo(w.y), bf_hi(w.y)}; }
template <int N, class XT> __device__ __forceinline__ void mod_rows(const XT* x, int nvalid, const float* m, bf16_t* o, int lane) {
    f32x4 v[N][4]; float ss[N];
#pragma unroll
    for (int i = 0; i < N; ++i)
#pragma unroll
        for (int j = 0; j < 4; ++j) { const size_t off = (size_t)(i < nvalid ? i : 0) * DM; if constexpr (sizeof(XT) == 4) v[i][j] = ((const f32x4*)((const float*)x + off))[lane + 64 * j]; else v[i][j] = ld_bf4((const bf16_t*)x + off + (lane + 64 * j) * 4); }
#pragma unroll
    for (int i = 0; i < N; ++i) { float t = 0.f;
#pragma unroll
        for (int j = 0; j < 4; ++j) t += (v[i][j][0] * v[i][j][0] + v[i][j][1] * v[i][j][1]) + (v[i][j][2] * v[i][j][2] + v[i][j][3] * v[i][j][3]);
        ss[i] = rsqrtf(wave_sum(t) * (1.0f / DM) + EPS); }
#pragma unroll
    for (int j = 0; j < 4; ++j) { const f32x4 sh = ((const f32x4*)m)[lane + 64 * j], sc = ((const f32x4*)(m + DM))[lane + 64 * j] + 1.0f;
#pragma unroll
        for (int i = 0; i < N; ++i) if (i < nvalid) st_bf4(o + (size_t)i * DM + (lane + 64 * j) * 4, v[i][j] * ss[i] * sc + sh); }
}
__device__ __forceinline__ void p1_modulate0(const Args& a, int G) {
    const int lane = lane_id(), gw = blockIdx.x * 8 + a.wv, NGW = G * 8;
    const float* mod = (const float*)(a.ws + WS_MOD);
    for (int r = gw * 4; r < MTOK; r += NGW * 4) mod_rows<4, float>(a.in[I_X] + (size_t)r * DM, 4, mod + (size_t)(r >> 12) * 6144, (bf16_t*)(a.ws + WS_H) + (size_t)r * DM, lane);
    for (int r = gw; r < MCTX; r += NGW) mod_rows<1, float>(a.in[I_CTX] + (size_t)r * DM, 1, mod + (size_t)4 * 6144, (bf16_t*)(a.ws + WS_HC) + (size_t)r * DM, lane);
}
__device__ __forceinline__ void p5_modulate1(const Args& a, int G) {
    const int lane = lane_id(), gw = blockIdx.x * 8 + a.wv, NGW = G * 8;
    const float* mod = (const float*)(a.ws + WS_MOD); const bf16_t* XR = (const bf16_t*)(a.ws + WS_XR);
    for (int r = gw * 4; r < MTOK; r += NGW * 4) mod_rows<4, bf16_t>(XR + (size_t)r * DM, 4, mod + (size_t)(r >> 12) * 6144 + 3 * DM, (bf16_t*)(a.ws + WS_H) + (size_t)r * DM, lane);
}

__device__ __forceinline__ float pmax32(float m) { auto rr = __builtin_amdgcn_permlane32_swap(__float_as_uint(m), __float_as_uint(m), false, false); return fmaxf(__uint_as_float(rr[0]), __uint_as_float(rr[1])); }
__device__ __forceinline__ float psum32(float m) { auto rr = __builtin_amdgcn_permlane32_swap(__float_as_uint(m), __float_as_uint(m), false, false); return __uint_as_float(rr[0]) + __uint_as_float(rr[1]); }
__device__ __forceinline__ bf16x8 pack8(const f32x16& p, int b) {
    u32x4 w; w.x = cvt_pk_bf16(p[b + 0], p[b + 1]); w.y = cvt_pk_bf16(p[b + 2], p[b + 3]); w.z = cvt_pk_bf16(p[b + 4], p[b + 5]); w.w = cvt_pk_bf16(p[b + 6], p[b + 7]);
    return __builtin_bit_cast(bf16x8, w);
}
constexpr float ATT_THR = 4.0f;
__device__ __forceinline__ void attn_tile(const LAS bf16_t* Kt, const LAS bf16_t* Vt, int vrs, int mode, const bf16x8 (&qf)[4], float& m_run, float& l_run, f32x16& O0, f32x16& O1, int qq0, int r32, int hi) {
    f32x16 p0 = {}, p1 = {};
#pragma unroll
    for (int d0 = 0; d0 < 4; ++d0) { const bf16x8 k0 = *(const LAS bf16x8*)(Kt + r32 * 72 + 16 * d0 + 8 * hi), k1 = *(const LAS bf16x8*)(Kt + (32 + r32) * 72 + 16 * d0 + 8 * hi);
        p0 = __builtin_amdgcn_mfma_f32_32x32x16_bf16(k0, qf[d0], p0, 0, 0, 0); p1 = __builtin_amdgcn_mfma_f32_32x32x16_bf16(k1, qf[d0], p1, 0, 0, 0); }
    if (mode == 1) { const int d = qq0 + r32 - 4 * hi;
#pragma unroll
        for (int r = 0; r < 16; ++r) { const int cr = (r & 3) + 8 * (r >> 2); p0[r] = cr >= d ? p0[r] : -1e30f; p1[r] = cr + 32 >= d ? p1[r] : -1e30f; } }
    else if (mode == 2) { const int d = qq0 + r32 - 4 * hi;
#pragma unroll
        for (int r = 0; r < 16; ++r) { const int cr = (r & 3) + 8 * (r >> 2); p0[r] = cr <= d ? p0[r] : -1e30f; p1[r] = cr + 32 <= d ? p1[r] : -1e30f; } }
    { const float nm = -m_run; p0 = p0 + nm; p1 = p1 + nm; }
#define MAX3(a, b, c) ([&]{ float r_; asm("v_max3_f32 %0, %1, %2, %3" : "=v"(r_) : "v"(a), "v"(b), "v"(c)); return r_; }())
    float mx;
    { const float a0 = MAX3(p0[0], p0[1], p0[2]), a1 = MAX3(p0[3], p0[4], p0[5]), a2 = MAX3(p0[6], p0[7], p0[8]), a3 = MAX3(p0[9], p0[10], p0[11]), a4 = MAX3(p0[12], p0[13], p0[14]);
      const float b0 = MAX3(p1[0], p1[1], p1[2]), b1 = MAX3(p1[3], p1[4], p1[5]), b2 = MAX3(p1[6], p1[7], p1[8]), b3 = MAX3(p1[9], p1[10], p1[11]), b4 = MAX3(p1[12], p1[13], p1[14]);
      const float c0 = MAX3(a0, a1, a2), c1 = MAX3(a3, a4, p0[15]), c2 = MAX3(b0, b1, b2), c3 = MAX3(b3, b4, p1[15]);
      const float e0 = MAX3(c0, c1, c2); asm("v_max_f32 %0, %1, %2" : "=v"(mx) : "v"(e0), "v"(c3)); }
#undef MAX3
    mx = pmax32(mx);
    if (__any(mx > ATT_THR)) {
        const float dl = fmaxf(mx, 0.0f), alpha = fast_exp2(-dl); m_run += dl; l_run *= alpha;
#pragma unroll
        for (int r = 0; r < 16; ++r) { O0[r] *= alpha; O1[r] *= alpha; }
        { const float nd = -dl; p0 = p0 + nd; p1 = p1 + nd; } }
#pragma unroll
    for (int r = 0; r < 16; ++r) { p0[r] = fast_exp2(p0[r]); p1[r] = fast_exp2(p1[r]); }
    { const f32x16 ps = p0 + p1;
      const f32x4 q4 = (f32x4){ps[0], ps[1], ps[2], ps[3]} + (f32x4){ps[4], ps[5], ps[6], ps[7]} + ((f32x4){ps[8], ps[9], ps[10], ps[11]} + (f32x4){ps[12], ps[13], ps[14], ps[15]});
      l_run += (q4[0] + q4[1]) + (q4[2] + q4[3]); }
    bf16x8 pb[4]; pb[0] = pack8(p0, 0); pb[1] = pack8(p0, 8); pb[2] = pack8(p1, 0); pb[3] = pack8(p1, 8);
#pragma unroll
    for (int kg = 0; kg < 4; ++kg) { const bf16x8 v0 = *(const LAS bf16x8*)(Vt + r32 * vrs + 16 * kg + 8 * hi), v1 = *(const LAS bf16x8*)(Vt + (32 + r32) * vrs + 16 * kg + 8 * hi);
        O0 = __builtin_amdgcn_mfma_f32_32x32x16_bf16(v0, pb[kg], O0, 0, 0, 0); O1 = __builtin_amdgcn_mfma_f32_32x32x16_bf16(v1, pb[kg], O1, 0, 0, 0); }
}
__device__ __forceinline__ int permkey(int k) { return (k & ~12) | ((k & 4) << 1) | ((k & 8) >> 1); }
constexpr int ACH_VRS = 136, ACH_KB = 128 * 72 * 2, ACH_B = ACH_KB + 64 * ACH_VRS * 2;
__device__ __forceinline__ void attn_unit(LAS unsigned char* lds, const bf16_t* PROJ, const bf16_t* KVC, const float* sink, bf16_t* MIX, int b, int n, int h, int wv) {
    const int tid = TIDX_OF(wv), lane = tid & 63, wid = wv, r32 = lane & 31, hi = lane >> 5;
    const int g = wid >> 1, half = wid & 1, hq = h * 4 + g;
    const int rowq = b * SEQ + n * 128 + half * 64;
    bf16x8 qf[2][4];
#pragma unroll
    for (int qb = 0; qb < 2; ++qb)
#pragma unroll
        for (int d0 = 0; d0 < 4; ++d0) qf[qb][d0] = *(const bf16x8*)(PROJ + (size_t)(rowq + qb * 32 + r32) * INW + hq * 64 + d0 * 16 + hi * 8);
    float m_run[2], l_run[2]; f32x16 O[2][2];
    const float sl2 = sink[hq] * LOG2E;
#pragma unroll
    for (int qb = 0; qb < 2; ++qb) { m_run[qb] = sl2; l_run[qb] = hi == 0 ? 1.0f : 0.0f; O[qb][0] = f32x16{}; O[qb][1] = f32x16{}; }
    const int krow0 = tid >> 3, kch = tid & 7, vkey = tid & 127, vch = tid >> 7, vpk = permkey(vkey);
    u32x4 kreg[2], vreg[2];
    const int c0 = n == 0 ? 1 : 0;
#define ATT_SRC(c, kp, vp, ld) const bf16_t* kp; int ld; if ((c) < 3) { kp = PROJ + ((size_t)b * SEQ + (size_t)(n - 1 + (c)) * 128) * INW + 512 + h * 64; ld = INW; } else { kp = KVC + ((size_t)b * CTXL + ((c) - 3) * 128) * 256 + h * 64; ld = 256; } const bf16_t* vp = kp + 128;
#define ATT_LOAD(c) do { ATT_SRC(c, kp_, vp_, ld_) \
        _Pragma("unroll") for (int i = 0; i < 2; ++i) { kreg[i] = *(const u32x4*)(kp_ + (size_t)(krow0 + 64 * i) * ld_ + kch * 8); vreg[i] = *(const u32x4*)(vp_ + (size_t)vkey * ld_ + (vch + 4 * i) * 8); } } while (0)
#define ATT_WRITE(buf) do { LAS bf16_t* KS_ = (LAS bf16_t*)(lds + (buf) * ACH_B); LAS bf16_t* VT_ = (LAS bf16_t*)(lds + (buf) * ACH_B + ACH_KB); \
        _Pragma("unroll") for (int i = 0; i < 2; ++i) { *(LAS u32x4*)(KS_ + (krow0 + 64 * i) * 72 + kch * 8) = kreg[i]; LAS bf16_t* vq = VT_ + ((vch + 4 * i) * 8) * ACH_VRS + vpk; const u32x4 v = vreg[i]; \
            vq[0 * ACH_VRS] = (bf16_t)(v.x & 0xffff); vq[1 * ACH_VRS] = (bf16_t)(v.x >> 16); vq[2 * ACH_VRS] = (bf16_t)(v.y & 0xffff); vq[3 * ACH_VRS] = (bf16_t)(v.y >> 16); \
            vq[4 * ACH_VRS] = (bf16_t)(v.z & 0xffff); vq[5 * ACH_VRS] = (bf16_t)(v.z >> 16); vq[6 * ACH_VRS] = (bf16_t)(v.w & 0xffff); vq[7 * ACH_VRS] = (bf16_t)(v.w >> 16); } } while (0)
    ATT_LOAD(c0); ATT_WRITE(0);
    __syncthreads();
    int buf = 0;
#pragma unroll 1
    for (int c = c0; c < 5; ++c) {
        if (c == 2 && n == 31) continue;
        int cn = c + 1; if (cn == 2 && n == 31) cn = 3;
        if (cn < 5) ATT_LOAD(cn);
        const LAS bf16_t* KS = (const LAS bf16_t*)(lds + buf * ACH_B); const LAS bf16_t* VT = (const LAS bf16_t*)(lds + buf * ACH_B + ACH_KB);
#pragma unroll 1
        for (int t = 0; t < 2; ++t) {
            int mode = 0;
            if (c < 3) { const int rel = 2 * (c - 1) + t - half; if (rel < -2 || rel > 2) continue; mode = rel == -2 ? 1 : (rel == 2 ? 2 : 0); }
#pragma unroll
            for (int qb = 0; qb < 2; ++qb) { attn_tile(KS + 64 * t * 72, VT + 64 * t, ACH_VRS, mode, qf[qb], m_run[qb], l_run[qb], O[qb][0], O[qb][1], qb * 32, r32, hi); __builtin_amdgcn_sched_barrier(0); }
        }
        if (cn < 5) ATT_WRITE(buf ^ 1);
        __syncthreads();
        buf ^= 1;
    }
#undef ATT_SRC
#undef ATT_LOAD
#undef ATT_WRITE
#pragma unroll
    for (int qb = 0; qb < 2; ++qb) { const float inv = 1.0f / psum32(l_run[qb]); bf16_t* op = MIX + (size_t)(rowq + qb * 32 + r32) * DM + hq * 64 + 4 * hi;
#pragma unroll
        for (int db = 0; db < 2; ++db)
#pragma unroll
            for (int rq = 0; rq < 4; ++rq) st_bf4(op + 32 * db + 8 * rq, (f32x4){O[qb][db][4 * rq] * inv, O[qb][db][4 * rq + 1] * inv, O[qb][db][4 * rq + 2] * inv, O[qb][db][4 * rq + 3] * inv}); }
}
__device__ __forceinline__ void gate_unit(LAS unsigned char* lds, const bf16_t* PROJ, const float* ssq, const float* gm_w_s, const float* gm_gain, const float* gm_b_s, bf16_t* MIX, int g, int b, int cq, int wv) {
    const int tid = TIDX_OF(wv), lane = tid & 63, wid = wv, r32 = lane & 31, hi = lane >> 5;
    LAS bf16_t* WS = (LAS bf16_t*)lds;
    const int s_ = tid & 127, ch = tid >> 7;
    const f32x4 ga0 = *(const f32x4*)(gm_gain + g * 64 + ch * 8), ga1 = *(const f32x4*)(gm_gain + g * 64 + ch * 8 + 4), gb0 = *(const f32x4*)(gm_gain + g * 64 + ch * 8 + 32), gb1 = *(const f32x4*)(gm_gain + g * 64 + ch * 8 + 36);
    u32x4 vreg[2]; f32x4 sq[2];
#define GT_LOAD(ck) do { const size_t row_ = (size_t)b * SEQ + (size_t)(ck) * 128 + s_; \
        vreg[0] = *(const u32x4*)(PROJ + row_ * INW + 1280 + g * 64 + ch * 8); vreg[1] = *(const u32x4*)(PROJ + row_ * INW + 1280 + g * 64 + (ch + 4) * 8); \
        sq[0] = *(const f32x4*)(ssq + row_ * 8); sq[1] = *(const f32x4*)(ssq + row_ * 8 + 4); } while (0)
#define GT_WRITE(buf) do { LAS bf16_t* VnT_ = (LAS bf16_t*)(lds + 34816 + (buf) * 17408); \
        const float rstd_ = rsqrtf((((sq[0][0] + sq[0][1]) + (sq[0][2] + sq[0][3])) + ((sq[1][0] + sq[1][1]) + (sq[1][2] + sq[1][3]))) * (1.0f / 512.0f) + EPS); \
        _Pragma("unroll") for (int i = 0; i < 2; ++i) { const u32x4 v = vreg[i]; const f32x4 g0 = (i ? gb0 : ga0) * rstd_, g1 = (i ? gb1 : ga1) * rstd_; \
            const unsigned w0 = cvt_pk_bf16(bf_lo(v.x) * g0[0], bf_hi(v.x) * g0[1]), w1 = cvt_pk_bf16(bf_lo(v.y) * g0[2], bf_hi(v.y) * g0[3]), w2 = cvt_pk_bf16(bf_lo(v.z) * g1[0], bf_hi(v.z) * g1[1]), w3 = cvt_pk_bf16(bf_lo(v.w) * g1[2], bf_hi(v.w) * g1[3]); \
            LAS bf16_t* vp = VnT_ + ((ch + 4 * i) * 8) * 136 + s_; \
            vp[0 * 136] = (bf16_t)(w0 & 0xffff); vp[1 * 136] = (bf16_t)(w0 >> 16); vp[2 * 136] = (bf16_t)(w1 & 0xffff); vp[3 * 136] = (bf16_t)(w1 >> 16); \
            vp[4 * 136] = (bf16_t)(w2 & 0xffff); vp[5 * 136] = (bf16_t)(w2 >> 16); vp[6 * 136] = (bf16_t)(w3 & 0xffff); vp[7 * 136] = (bf16_t)(w3 >> 16); } } while (0)
    GT_LOAD(4 * cq);
#pragma unroll
    for (int it = 0; it < 4; ++it) { const int id = tid + 512 * it, t = id >> 4, c8 = id & 15; const float* wp = gm_w_s + ((size_t)g * 128 + t) * 128 + c8 * 8;
        const f32x4 w0 = *(const f32x4*)wp, w1 = *(const f32x4*)(wp + 4); u32x4 o; o.x = cvt_pk_bf16(w0[0], w0[1]); o.y = cvt_pk_bf16(w0[2], w0[3]); o.z = cvt_pk_bf16(w1[0], w1[1]); o.w = cvt_pk_bf16(w1[2], w1[3]);
        *(LAS u32x4*)(WS + t * 136 + c8 * 8) = o; }
    GT_WRITE(0);
    __syncthreads();
    const int wt = wid >> 1, wd = wid & 1, t = 32 * wt + r32; const float bias = gm_b_s[g * 128 + t];
#pragma unroll 1
    for (int k = 0; k < 4; ++k) { const int ck = 4 * cq + k, buf = k & 1; const size_t row = (size_t)b * SEQ + (size_t)ck * 128 + t;
        if (k < 3) GT_LOAD(ck + 1);
        u32x2 uu[4];
#pragma unroll
        for (int rq = 0; rq < 4; ++rq) uu[rq] = *(const u32x2*)(PROJ + row * INW + 768 + g * 64 + 32 * wd + 8 * rq + 4 * hi);
        const LAS bf16_t* VnT = (const LAS bf16_t*)(lds + 34816 + buf * 17408); f32x16 acc = {};
#pragma unroll
        for (int ks = 0; ks < 8; ++ks) { const bf16x8 af = *(const LAS bf16x8*)(VnT + (32 * wd + r32) * 136 + 16 * ks + 8 * hi), bfr = *(const LAS bf16x8*)(WS + (32 * wt + r32) * 136 + 16 * ks + 8 * hi);
            acc = __builtin_amdgcn_mfma_f32_32x32x16_bf16(af, bfr, acc, 0, 0, 0); }
#pragma unroll
        for (int rq = 0; rq < 4; ++rq) { const int d0 = 32 * wd + 8 * rq + 4 * hi;
            st_bf4(MIX + row * DM + 512 + g * 64 + d0, (f32x4){bf_lo(uu[rq].x) * (acc[4 * rq] + bias), bf_hi(uu[rq].x) * (acc[4 * rq + 1] + bias), bf_lo(uu[rq].y) * (acc[4 * rq + 2] + bias), bf_hi(uu[rq].y) * (acc[4 * rq + 3] + bias)}); }
        if (k < 3) GT_WRITE(buf ^ 1);
        __syncthreads();
    }
#undef GT_LOAD
#undef GT_WRITE
}
__device__ __forceinline__ void p3_mixers(const Args& a, LAS unsigned char* lds, int G) {
    const bf16_t* PROJ = (const bf16_t*)(a.ws + WS_PROJ); const bf16_t* KVC = (const bf16_t*)(a.ws + WS_KVC); bf16_t* MIX = (bf16_t*)(a.ws + WS_MIX);
    for (int u = blockIdx.x; u < 256; u += G) attn_unit(lds, PROJ, KVC, a.in[I_SINK], MIX, u >> 6, (u >> 1) & 31, u & 1, a.wv);
    for (int u = blockIdx.x; u < 256; u += G) gate_unit(lds, PROJ, (const float*)(a.ws + WS_SSQ), a.in[I_GMWS], a.in[I_GMGAIN], a.in[I_GMBS], MIX, u & 7, u >> 6, (u >> 3) & 7, a.wv);
}

template <int W> __device__ __forceinline__ void pool_half(const bf16_t* xc, bf16_t* dp, const LAS float* rsp, int lo, int tb, f32x2 sc) {
    constexpr int BEF = W / 2, AFT = W - 1 - BEF, NR = 32 + W - 1;
    f32x2 xv[NR];
#pragma unroll
    for (int k = 0; k < NR; ++k) { const int j = tb - BEF + k; xv[k] = (j >= 0 && j <= SEQ - 1) ? ld_bf2(xc + (size_t)j * DM) : (f32x2){0.f, 0.f}; }
#pragma unroll
    for (int k = 0; k < NR; ++k) { const int j = tb - BEF + k; xv[k] = xv[k] * ((j >= 0 && j <= SEQ - 1) ? rsp[j - lo] : 0.f); }
    f32x2 sum = xv[0];
#pragma unroll
    for (int k = 1; k < W; ++k) sum = sum + xv[k];
#pragma unroll
    for (int i = 0; i < 32; ++i) { const int t = tb + i, l2 = t - BEF < 0 ? 0 : t - BEF, h2 = t + AFT > SEQ - 1 ? SEQ - 1 : t + AFT;
        const f32x2 d = (sum * (1.0f / (float)(h2 - l2 + 1)) - xv[i + BEF]) * sc;
        *(unsigned*)(dp + (size_t)t * DM) = cvt_pk_bf16(d[0], d[1]);
        if (i < 31) sum = sum + xv[i + W] - xv[i]; }
}
__device__ __forceinline__ void p8_pooldiff(const Args& a, LAS unsigned char* lds, int G) {
    const int tid = TIDX_OF(a.wv), lane = tid & 63, wid = a.wv;
    LAS float* rsp = (LAS float*)lds;
    const float* mod1 = (const float*)(a.ws + WS_MOD) + (size_t)5 * 6144; bf16_t* DIFF = (bf16_t*)(a.ws + WS_DIFF);
    for (int tile = blockIdx.x; tile < 256; tile += G) {
        const int r0 = tile * 64, b = r0 >> 12, t0 = r0 & (SEQ - 1), lo = t0 - 8 < 0 ? 0 : t0 - 8, hi = t0 + 71 > SEQ - 1 ? SEQ - 1 : t0 + 71, nrows = hi - lo + 1;
        const bf16_t* xb = (const bf16_t*)(a.ws + WS_XR) + (size_t)b * SEQ * DM;
        if (tid < nrows) { const f32x4* sp = (const f32x4*)((const float*)(a.ws + WS_SSQ2) + (size_t)(b * SEQ + lo + tid) * 64);
            f32x4 sv[16];
#pragma unroll
            for (int k = 0; k < 16; ++k) sv[k] = sp[k];
            f32x4 t4 = sv[0];
#pragma unroll
            for (int k = 1; k < 16; ++k) t4 = t4 + sv[k];
            rsp[tid] = rsqrtf(((t4[0] + t4[1]) + (t4[2] + t4[3])) * (1.0f / DM) + EPS); }
        __syncthreads();
        const int c = 2 * tid, gi = c >> 8;
        const f32x2 sc = *(const f32x2*)(mod1 + (size_t)b * 6144 + DM + c) + 1.0f;
        bf16_t* dp = DIFF + (size_t)(b * SEQ) * DM + c;
#pragma unroll 1
        for (int hf = 0; hf < 2; ++hf) { const int tb = t0 + 32 * hf;
            if (gi == 0) pool_half<2>(xb + c, dp, rsp, lo, tb, sc); else if (gi == 1) pool_half<4>(xb + c, dp, rsp, lo, tb, sc); else if (gi == 2) pool_half<8>(xb + c, dp, rsp, lo, tb, sc); else pool_half<16>(xb + c, dp, rsp, lo, tb, sc); }
        __syncthreads();
    }
}

__device__ __forceinline__ void p10_router(const Args& a, LAS unsigned char* lds, int G) {
    const int tid = TIDX_OF(a.wv), lane = tid & 63, wid = a.wv;
    LAS float* RW = (LAS float*)lds;
    LAS int* esel = (LAS int*)(lds + 32768);
    { float rwv[16];
#pragma unroll
      for (int k = 0; k < 16; ++k) rwv[k] = a.in[I_RW][tid + 512 * k];
#pragma unroll
      for (int k = 0; k < 16; ++k) { const int idx = tid + 512 * k; RW[(idx & 7) * DM + (idx >> 3)] = rwv[k]; } }
    __syncthreads();
    const float* mod1 = (const float*)(a.ws + WS_MOD) + (size_t)5 * 6144;
    int* rte = (int*)(a.ws + WS_RTE); float* rtw = (float*)(a.ws + WS_RTW); int* cntb = (int*)(a.ws + WS_CNTB);
    unsigned char* H8 = a.ws + WS_H;
    for (int tile = blockIdx.x; tile < 256; tile += G) {
        const bf16_t* XR = (const bf16_t*)(a.ws + WS_XR);
#pragma unroll 1
        for (int st = 0; st < 2; ++st) {
            const int lr0 = wid * 8 + st * 4, row0 = tile * 64 + lr0, b = row0 >> 12;
            f32x4 v[4][4]; float rstd[4];
#pragma unroll
            for (int i = 0; i < 4; ++i)
#pragma unroll
                for (int j = 0; j < 4; ++j) v[i][j] = ld_bf4(XR + (size_t)(row0 + i) * DM + (lane + 64 * j) * 4);
#pragma unroll
            for (int i = 0; i < 4; ++i) { float ss = 0.f;
#pragma unroll
                for (int j = 0; j < 4; ++j) ss += (v[i][j][0] * v[i][j][0] + v[i][j][1] * v[i][j][1]) + (v[i][j][2] * v[i][j][2] + v[i][j][3] * v[i][j][3]);
                rstd[i] = rsqrtf(wave_sum(ss) * (1.0f / DM) + EPS); }
            const float* mb = mod1 + (size_t)b * 6144 + 3 * DM;
            float lg[4][8];
#pragma unroll
            for (int i = 0; i < 4; ++i)
#pragma unroll
                for (int e = 0; e < 8; ++e) lg[i][e] = 0.f;
#pragma unroll
            for (int j = 0; j < 4; ++j) { const f32x4 sh = ((const f32x4*)mb)[lane + 64 * j], sc = ((const f32x4*)(mb + DM))[lane + 64 * j] + 1.0f;
#pragma unroll
                for (int i = 0; i < 4; ++i) { v[i][j] = v[i][j] * rstd[i] * sc + sh;
                    const f32x4 h8 = v[i][j] * HSC; *(unsigned*)(H8 + (size_t)(row0 + i) * DM + (lane + 64 * j) * 4) = pk_fp8x4(h8[0], h8[1], h8[2], h8[3]); }
#pragma unroll
                for (int e = 0; e < 8; ++e) { const f32x4 w = *(const LAS f32x4*)(RW + e * DM + (lane + 64 * j) * 4);
#pragma unroll
                    for (int i = 0; i < 4; ++i) lg[i][e] += (v[i][j][0] * w[0] + v[i][j][1] * w[1]) + (v[i][j][2] * w[2] + v[i][j][3] * w[3]); } }
#pragma unroll
            for (int i = 0; i < 4; ++i) {
#pragma unroll
                for (int e = 0; e < 8; ++e) lg[i][e] = wave_sum(lg[i][e]);
                float v0 = lg[i][0]; int i0 = 0;
#pragma unroll
                for (int e = 1; e < 8; ++e) if (lg[i][e] > v0) { v0 = lg[i][e]; i0 = e; }
                float v1 = -3.0e38f; int i1 = 0;
#pragma unroll
                for (int e = 0; e < 8; ++e) if (e != i0 && lg[i][e] > v1) { v1 = lg[i][e]; i1 = e; }
                const float ex = __expf(v1 - v0), w0 = 1.0f / (1.0f + ex), w1 = ex * w0; const int row = row0 + i, lr = lr0 + i;
                if (lane == 0) { rte[row * 2] = i0; rte[row * 2 + 1] = i1; rtw[row * 2] = w0; rtw[row * 2 + 1] = w1; esel[lr * 2] = i0; esel[lr * 2 + 1] = i1; } }
        }
        __syncthreads();
        if (tid < 8) { const int e = tid; int cnt = 0;
            for (int p = 0; p < 128; ++p) cnt += (esel[p] == e) ? 1 : 0;
            cntb[tile * 8 + e] = cnt; }
        __syncthreads();
    }
}
__device__ __forceinline__ void p10b_sort(const Args& a, LAS unsigned char* lds, int G) {
    const int tid = TIDX_OF(a.wv), lane = tid & 63, wid = a.wv;
    LAS int* cs = (LAS int*)lds;
    LAS int* basee = (LAS int*)(lds + 8192);
    LAS int* tote = (LAS int*)(lds + 8192 + 32);
    LAS int* w0cnt = (LAS int*)(lds + 8192 + 64);
    LAS int* dest = (LAS int*)(lds + 8192 + 128);
    const int* cntb = (const int*)(a.ws + WS_CNTB); const int* rte = (const int*)(a.ws + WS_RTE); int* pos = (int*)(a.ws + WS_POS); int* totg = (int*)(a.ws + WS_TOT);
    const unsigned char* H8 = a.ws + WS_H; unsigned char* XS = a.ws + WS_XS;
    for (int tile = blockIdx.x; tile < 256; tile += G) {
        for (int i = tid; i < 2048; i += 512) cs[i] = cntb[i];
        __syncthreads();
        { const int e = wid; int tsum = 0, bsum = 0;
#pragma unroll
          for (int k = 0; k < 4; ++k) { const int t = lane + 64 * k, v = cs[t * 8 + e]; tsum += v; bsum += t < tile ? v : 0; }
#pragma unroll
          for (int o = 1; o < 64; o <<= 1) { tsum += __shfl_xor(tsum, o); bsum += __shfl_xor(bsum, o); }
          if (lane == 0) { basee[e] = bsum; tote[e] = tsum; if (tile == 0) totg[e] = tsum; } }
        int mye = 0, rank = 0;
        if (wid < 2) { mye = rte[tile * 128 + tid];
#pragma unroll
            for (int e = 0; e < 8; ++e) { const unsigned long long bm = __ballot(mye == e); if (mye == e) rank = __popcll(bm & ((1ull << lane) - 1ull)); if (wid == 0 && lane == 0) w0cnt[e] = __popcll(bm); } }
        __syncthreads();
        if (wid < 2) { int rs = 0;
#pragma unroll
            for (int e = 0; e < 8; ++e) { const int te = tote[e]; if (e < mye) rs += (te + 255) >> 8; }
            const int d = rs * 256 + basee[mye] + rank + (wid == 1 ? w0cnt[mye] : 0);
            dest[tid] = d; pos[tile * 128 + tid] = d; }
        __syncthreads();
        { u32x4 cv[16];
#pragma unroll
          for (int pp = 0; pp < 16; ++pp) cv[pp] = *(const u32x4*)(H8 + (size_t)(tile * 64 + ((wid * 16 + pp) >> 1)) * DM + lane * 16);
#pragma unroll
          for (int pp = 0; pp < 16; ++pp) *(u32x4*)(XS + (size_t)dest[wid * 16 + pp] * DM + lane * 16) = cv[pp]; }
        __syncthreads();
    }
    { int nt = 0;
#pragma unroll
      for (int e = 0; e < 8; ++e) nt += (tote[e] + 255) >> 8;
      const int gp = moe_gu_groups(nt, G), hq = moe_h3_quota(G - gp), wave = a.wv;
      __syncthreads();
      moe_stream(a, (LAS float*)(lds + wave * 16896), MOE_X2 + hq + blockIdx.x * 8 + wave, NMOE, G * 8, lane); }
}

__device__ __forceinline__ u32x2 ysplit(const bf16_t* YS, int row, int col) {
    f32x4 acc = {0.f, 0.f, 0.f, 0.f};
#pragma unroll
    for (int kc = 0; kc < 7; ++kc) acc = acc + ld_bf4(YS + ((size_t)kc * 2048 + row) * DM + col);
    u32x2 w; w.x = cvt_pk_bf16(acc[0], acc[1]); w.y = cvt_pk_bf16(acc[2], acc[3]); return w;
}
__device__ __forceinline__ void p13_final(const Args& a, int G, bool use_y) {
    const int lane = lane_id(), wave = a.wv, gw = blockIdx.x * 8 + wave, NGW = G * 8;
    const float* mod1 = (const float*)(a.ws + WS_MOD) + (size_t)5 * 6144; const bf16_t* Y = (const bf16_t*)(a.ws + WS_Y); const int* pos = (const int*)(a.ws + WS_POS); const float* rtw = (const float*)(a.ws + WS_RTW);
    MoeTiles T; T.init((const int*)(a.ws + WS_TOT)); const int nsplit = moe_nsplit(T.p8, G), split0 = (T.p8 - nsplit) * 256; const bf16_t* YS = (const bf16_t*)(a.ws + WS_YS);
#define LDY(q, j) ((q) < split0 ? *(const u32x2*)(Y + (size_t)(q) * DM + (lane + 64 * (j)) * 4) : ysplit(YS, (q) - split0, (lane + 64 * (j)) * 4))
    for (int r0 = gw; r0 < MTOK; r0 += 2 * NGW) {
        const bool two = r0 + NGW < MTOK; const int rA = r0, rB = two ? r0 + NGW : r0;
        const int qa0 = pos[2 * rA], qa1 = pos[2 * rA + 1], qb0 = pos[2 * rB], qb1 = pos[2 * rB + 1];
        const float wa0 = rtw[2 * rA], wa1 = rtw[2 * rA + 1], wb0 = rtw[2 * rB], wb1 = rtw[2 * rB + 1];
        f32x4* xa = (f32x4*)(a.out + (size_t)rA * DM) + lane; f32x4* xb = (f32x4*)(a.out + (size_t)rB * DM) + lane;
        const bf16_t* xia = (const bf16_t*)(a.ws + WS_XR) + (size_t)rA * DM; const bf16_t* xib = (const bf16_t*)(a.ws + WS_XR) + (size_t)rB * DM;
        const float* ga = mod1 + (size_t)(rA >> 12) * 6144 + 5 * DM; const float* gb = mod1 + (size_t)(rB >> 12) * 6144 + 5 * DM;
        f32x4 va[4], vb[4]; u32x2 ya0[4], ya1[4], yb0[4], yb1[4];
#pragma unroll
        for (int j = 0; j < 4; ++j) { va[j] = ld_bf4(xia + (lane + 64 * j) * 4); vb[j] = ld_bf4(xib + (lane + 64 * j) * 4);
            ya0[j] = LDY(qa0, j); ya1[j] = LDY(qa1, j); yb0[j] = LDY(qb0, j); yb1[j] = LDY(qb1, j); }
        float sa = 0.f, sb = 0.f;
#pragma unroll
        for (int j = 0; j < 4; ++j) {
            if (use_y) { const f32x4 ysa = (f32x4){wa0 * bf_lo(ya0[j].x) + wa1 * bf_lo(ya1[j].x), wa0 * bf_hi(ya0[j].x) + wa1 * bf_hi(ya1[j].x), wa0 * bf_lo(ya0[j].y) + wa1 * bf_lo(ya1[j].y), wa0 * bf_hi(ya0[j].y) + wa1 * bf_hi(ya1[j].y)};
                const f32x4 ysb = (f32x4){wb0 * bf_lo(yb0[j].x) + wb1 * bf_lo(yb1[j].x), wb0 * bf_hi(yb0[j].x) + wb1 * bf_hi(yb1[j].x), wb0 * bf_lo(yb0[j].y) + wb1 * bf_lo(yb1[j].y), wb0 * bf_hi(yb0[j].y) + wb1 * bf_hi(yb1[j].y)};
                va[j] = va[j] + ((const f32x4*)ga)[lane + 64 * j] * ysa; vb[j] = vb[j] + ((const f32x4*)gb)[lane + 64 * j] * ysb; }
            sa += (va[j][0] * va[j][0] + va[j][1] * va[j][1]) + (va[j][2] * va[j][2] + va[j][3] * va[j][3]); sb += (vb[j][0] * vb[j][0] + vb[j][1] * vb[j][1]) + (vb[j][2] * vb[j][2] + vb[j][3] * vb[j][3]); }
        sa = wave_sum(sa); sb = wave_sum(sb);
        const float ra = rsqrtf(sa * (1.0f / DM) + EPS), rb = rsqrtf(sb * (1.0f / DM) + EPS);
#pragma unroll
        for (int j = 0; j < 4; ++j) { const f32x4 fg = ((const f32x4*)a.in[I_FGAIN])[lane + 64 * j]; xa[64 * j] = va[j] * ra * fg; if (two) xb[64 * j] = vb[j] * rb * fg; }
    }
}

constexpr int NPHASE = 16;
constexpr int ARGTAB_OFF = LDSCTL_OFF + 256;
__device__ __forceinline__ unsigned long long ld_u64_uniform(LAS unsigned char* lds, int k) {
    const u32x2 v = *(const LAS u32x2*)(lds + ARGTAB_OFF + 8 * k);
    return ((unsigned long long)(unsigned)__builtin_amdgcn_readfirstlane((int)v.y) << 32) | (unsigned)__builtin_amdgcn_readfirstlane((int)v.x);
}
__device__ __forceinline__ void load_args(Args& a, LAS unsigned char* lds) {
#pragma unroll
    for (int k = 0; k < 22; ++k) a.in[k] = (const float*)(GAS const float*)ld_u64_uniform(lds, k);
    a.out = (float*)(GAS float*)ld_u64_uniform(lds, 22); a.ws = (unsigned char*)(GAS unsigned char*)ld_u64_uniform(lds, 23);
}
__global__ void __launch_bounds__(512, 2) dit_fwd(Args args) {
    extern __shared__ __attribute__((aligned(16))) unsigned char lds_raw[];
    LAS unsigned char* lds = (LAS unsigned char*)lds_raw;
    const int tid = threadIdx.x, G = gridDim.x, wv = __builtin_amdgcn_readfirstlane(tid >> 6);
    for (int u = tid; u < (LDS_BYTES - LDSCTL_OFF) / 4; u += 512) ((LAS unsigned*)(lds + LDSCTL_OFF))[u] = 0u;
    __syncthreads();
    if (tid == 0) { LAS unsigned long long* tab = (LAS unsigned long long*)(lds + ARGTAB_OFF);
#pragma unroll
        for (int k = 0; k < 22; ++k) tab[k] = (unsigned long long)args.in[k];
        tab[22] = (unsigned long long)args.out; tab[23] = (unsigned long long)args.ws; }
    __syncthreads();
#if MK_ONE_LAUNCH
    (void)xcd_barrier_post((unsigned*)(args.ws + WS_CTL) + CW_BAR, (volatile LAS unsigned*)(lds + LDSCTL_OFF + 64), wv);
#define GRID_BAR() do { XcdBarrier bar_; bar_.bar = (unsigned*)(GAS unsigned*)(ld_u64_uniform(lds, 23) + WS_CTL) + CW_BAR; bar_.x = xb_xcc_id(); bar_.st = (volatile LAS unsigned*)(lds + LDSCTL_OFF + 64); bar_.wv = wv; xcd_barrier(bar_); } while (0)
#else
#define GRID_BAR() do {} while (0)
#endif
    const int lo = args.ph_lo, hi = args.ph_hi;
#ifdef PH_ONLY
#define IN(k) ((k) == PH_ONLY && lo <= (k) && (k) < hi)
#else
#define IN(k) (lo <= (k) && (k) < hi)
#endif
#define SEAM(k) do { if (IN(k) && IN((k) + 1)) GRID_BAR(); } while (0)
#define PH_BEGIN Args a; load_args(a, lds); a.wv = wv; unsigned char* ws = a.ws; float* mod = (float*)(ws + WS_MOD); (void)mod;

    if (IN(0)) { PH_BEGIN p0_prologue(a, lds, G); } SEAM(0);
    if (IN(1)) { PH_BEGIN p0b_modreduce(a, G); } SEAM(1);
    if (IN(2)) { PH_BEGIN p1_modulate0(a, G); } SEAM(2);
    if (IN(3)) { PH_BEGIN const int gp = G == 256 ? GP_PROJ : G; if ((int)blockIdx.x >= gp) { moe_convert_range(a, lds, MOE_X0, MOE_X1, (int)blockIdx.x - gp, G - gp); } else { JobProj J; J.KB = DM * 2; J.ldab = DM * 2; J.G = gp; J.c = blockIdx.x; J.H = (const bf16_t*)(ws + WS_H); J.WT = (const bf16_t*)(ws + WS_WIN); J.PROJ = (bf16_t*)(ws + WS_PROJ); J.KVC = (bf16_t*)(ws + WS_KVC); J.rope = (const float*)(ws + WS_ROPE); J.ssq = (float*)(ws + WS_SSQ);
        pg8::gemm_phase<JobProj, true>(lds, J, a.wv); } } SEAM(3);
    if (IN(4)) { PH_BEGIN p3_mixers(a, lds, G); } SEAM(4);
    if (IN(5)) { PH_BEGIN JobRes<false, true> J; J.KB = DM * 2; J.ldab = DM * 2; J.ascale = 1.0f; J.G = G; J.c = blockIdx.x; J.pool = 0; J.A = ws + WS_MIX; J.Bt = ws + WS_WOUT; J.xin = a.in[I_X]; J.xout = (bf16_t*)(ws + WS_XR); J.gate = mod + 2 * DM; J.cscale = nullptr; J.ssq2 = nullptr;
        pg8::gemm_phase<JobRes<false, true>, true>(lds, J, a.wv); } SEAM(5);
    if (IN(6)) { PH_BEGIN p5_modulate1(a, G); } SEAM(6);
    if (IN(7)) { PH_BEGIN const int gp = G == 256 ? GP_GU : G; if ((int)blockIdx.x >= gp) { moe_convert_range(a, lds, MOE_X1, MOE_X2, (int)blockIdx.x - gp, G - gp); } else { JobGU J; J.KB = DM * 2; J.ldab = DM * 2; J.G = gp; J.c = blockIdx.x; J.H = (const bf16_t*)(ws + WS_H); J.WT = (const bf16_t*)(ws + WS_WGU); J.ACT = ws + WS_ACTF;
        pg8::gemm_phase<JobGU, true>(lds, J, a.wv); } } SEAM(7);
    if (IN(8)) { PH_BEGIN JobRes<true, false> J; J.KB = FFD; J.ldab = FFD; J.ascale = 1.0f / (WSC * ASC); J.G = G; J.c = blockIdx.x; J.pool = 0; J.A = ws + WS_ACTF; J.Bt = ws + WS_WDN; J.xin = ws + WS_XR; J.xout = (bf16_t*)(ws + WS_XR); J.gate = mod + 5 * DM; J.cscale = nullptr; J.ssq2 = (float*)(ws + WS_SSQ2);
        pg8::gemm_phase<JobRes<true, false>, true>(lds, J, a.wv); } SEAM(8);
    if (IN(9)) { PH_BEGIN p8_pooldiff(a, lds, G); } SEAM(9);
    if (IN(10)) { PH_BEGIN JobRes<false, false> J; J.KB = 512; J.ldab = DM * 2; J.ascale = 1.0f; J.G = G; J.c = blockIdx.x; J.pool = 1; J.A = ws + WS_DIFF; J.Bt = ws + WS_WPOOL; J.xin = ws + WS_XR; J.xout = (bf16_t*)(ws + WS_XR); J.gate = mod + 5 * 6144 + 2 * DM; J.cscale = a.in[I_PSC]; J.ssq2 = nullptr;
        pg8::gemm_phase<JobRes<false, false>, true>(lds, J, a.wv); } SEAM(10);
    if (IN(11)) { PH_BEGIN p10_router(a, lds, G); } SEAM(11);
    if (IN(12)) { PH_BEGIN p10b_sort(a, lds, G); } SEAM(12);
    if (IN(13)) { PH_BEGIN JobMGU J; J.KB = DM; J.ldab = DM; J.c = blockIdx.x; J.T.init((const int*)(ws + WS_TOT)); J.XS = ws + WS_XS; J.WT = ws + WS_WMGU; J.ACT = ws + WS_BIG;
        const int gp = moe_gu_groups(J.T.p8, G), nh = G - gp, hq = moe_h3_quota(nh);
        J.G = gp;
        if ((int)blockIdx.x >= gp) moe_convert_range(a, lds, MOE_X2, MOE_X2 + hq, (int)blockIdx.x - gp, nh); else pg8::gemm_phase<JobMGU, true>(lds, J, a.wv); } SEAM(13);
    if (IN(14)) { PH_BEGIN JobMDown J; J.KB = FFE; J.ldab = FFE; J.G = G; J.c = blockIdx.x; J.T.init((const int*)(ws + WS_TOT)); J.ACT = ws + WS_BIG; J.WT = ws + WS_WMDN; J.Y = (bf16_t*)(ws + WS_Y); J.YS = (bf16_t*)(ws + WS_YS);
        J.nsplit = moe_nsplit(J.T.p8, G); J.nfull = J.T.p8 - J.nsplit;
        pg8::gemm_phase<JobMDown, true>(lds, J, a.wv); } SEAM(14);
    if (IN(15)) { PH_BEGIN p13_final(a, G, true); }
#undef IN
#undef SEAM
#undef PH_BEGIN
}

extern "C" void kernel_launch(void* const* d_in, const int* in_sizes, int n_in, void* d_out, int out_size, void* d_ws, size_t ws_size, hipStream_t stream) {
    static int grid = 0;
    if (grid == 0) {
        if (n_in != 22 || in_sizes[0] != MTOK * DM || out_size != MTOK * DM || ws_size < WS_END) { fprintf(stderr, "kernel_launch: unexpected shapes (n_in %d, in0 %d, out %d, ws %zu < %zu)\n", n_in, n_in > 0 ? in_sizes[0] : -1, out_size, ws_size, (size_t)WS_END); grid = -1; return; }
        int dev = 0, cus = 0, per_cu = 0;
        if (hipGetDevice(&dev) != hipSuccess || hipDeviceGetAttribute(&cus, hipDeviceAttributeMultiprocessorCount, dev) != hipSuccess) { grid = -1; return; }
        if (hipFuncSetAttribute((const void*)dit_fwd, hipFuncAttributeMaxDynamicSharedMemorySize, LDS_BYTES) != hipSuccess) { fprintf(stderr, "kernel_launch: hipFuncSetAttribute failed\n"); grid = -1; return; }
        if (hipOccupancyMaxActiveBlocksPerMultiprocessor(&per_cu, (const void*)dit_fwd, 512, LDS_BYTES) != hipSuccess || per_cu < 1) fprintf(stderr, "kernel_launch: occupancy query reports %d\n", per_cu);
        (void)hipGetLastError();
        grid = cus;
    }
    if (grid < 0) return;
    if (hipMemsetAsync((char*)d_ws + WS_CTL, 0, CTL_ZERO_BYTES, stream) != hipSuccess) return;
    Args a{};
    for (int i = 0; i < 22; ++i) a.in[i] = (const float*)d_in[i];
    a.out = (float*)d_out; a.ws = (unsigned char*)d_ws;
#if MK_ONE_LAUNCH
    a.ph_lo = 0; a.ph_hi = NPHASE;
    hipLaunchKernelGGL(dit_fwd, dim3(grid), dim3(512), LDS_BYTES, stream, a);
#else
    for (int p = 0; p < NPHASE; ++p) { a.ph_lo = p; a.ph_hi = p + 1; hipLaunchKernelGGL(dit_fwd, dim3(grid), dim3(512), LDS_BYTES, stream, a); }
#endif
}
```

```cpp
#include <hip/hip_runtime.h>
#include <cstdio>
#include <cstdint>

#ifndef MK_ONE_LAUNCH
#define MK_ONE_LAUNCH 1
#endif

#define LAS __attribute__((address_space(3)))
#define GAS __attribute__((address_space(1)))
typedef unsigned short bf16_t;
typedef short bf16x8 __attribute__((ext_vector_type(8)));
typedef float f32x2 __attribute__((ext_vector_type(2)));
typedef float f32x4 __attribute__((ext_vector_type(4)));
typedef float f32x16 __attribute__((ext_vector_type(16)));
typedef unsigned u32x2 __attribute__((ext_vector_type(2)));
typedef unsigned u32x4 __attribute__((ext_vector_type(4)));
typedef int i32x4 __attribute__((ext_vector_type(4)));
typedef int i32x8 __attribute__((ext_vector_type(8)));

constexpr int NB = 4, SEQ = 4096, DM = 1024, MTOK = NB * SEQ;
constexpr int CTXL = 256, MCTX = NB * CTXL;
constexpr int INW = 1792;
constexpr int FFD = 2816, FFE = 3584, NEXP = 8, NPAIR = MTOK * 2;
constexpr float EPS = 1e-6f, LOG2E = 1.4426950408889634f;
constexpr float QSCALE = 0.125f * LOG2E;

constexpr size_t MiB = 1u << 20;
constexpr size_t WS_CTL = 0, CTL_ZERO_BYTES = 1 * MiB;
constexpr size_t WS_MOD = 1 * MiB;
constexpr size_t WS_ROPE = 1 * MiB + 256 * 1024;
constexpr size_t WS_RTE = 1 * MiB + 320 * 1024;
constexpr size_t WS_RTW = 1 * MiB + 448 * 1024;
constexpr size_t WS_POS = 2 * MiB;
constexpr size_t WS_CNTB = 2 * MiB + 256 * 1024;
constexpr size_t WS_TOT = 2 * MiB + 320 * 1024;
constexpr size_t WS_PART = 3 * MiB;
constexpr size_t WS_SSQ2 = WS_PART + 1 * MiB;
constexpr size_t WS_SSQ = WS_PART;
constexpr size_t WS_WIN = 11 * MiB;
constexpr size_t WS_WOUT = 15 * MiB;
constexpr size_t WS_WGU = 17 * MiB;
constexpr size_t WS_WDN = 28 * MiB;
constexpr size_t WS_WPOOL = 34 * MiB;
constexpr size_t WS_HC = 35 * MiB;
constexpr size_t WS_H = 37 * MiB;
constexpr size_t WS_WMGU = 69 * MiB;
constexpr size_t WS_XS = 125 * MiB;
constexpr size_t WS_WMDN = 181 * MiB;
constexpr size_t WS_BIG = 237 * MiB;
constexpr size_t WS_PROJ = WS_BIG;
constexpr size_t WS_KVC = WS_BIG + 56 * MiB;
constexpr size_t WS_MIX = WS_BIG + 64 * MiB;
constexpr size_t WS_ACTF = WS_BIG + 96 * MiB;
constexpr size_t WS_DIFF = WS_BIG;
constexpr size_t WS_Y = WS_BIG + 128 * MiB;
constexpr size_t WS_YS = WS_BIG + 196 * MiB;
constexpr size_t WS_XR = 461 * MiB;
constexpr size_t WS_END = 493 * MiB;
constexpr int CW_BAR = 4096;

constexpr int RING_BYTES = 131072, LDSCTL_OFF = 139264, LDS_BYTES = 143360;
constexpr int MAXROWS = NPAIR + 8 * 256;

#define LDS_WAIT() asm volatile("s_waitcnt lgkmcnt(0)" ::: "memory")
#define VM_WAIT() asm volatile("s_waitcnt vmcnt(0)" ::: "memory")

typedef __bf16 bf16x2_t __attribute__((ext_vector_type(2)));
__device__ __forceinline__ unsigned cvt_pk_bf16(float lo, float hi) { const f32x2 v = {lo, hi}; const bf16x2_t b = __builtin_convertvector(v, bf16x2_t); return __builtin_bit_cast(unsigned, b); }
__device__ __forceinline__ float clamp448(float x) { return fminf(fmaxf(x, -448.0f), 448.0f); }
__device__ __forceinline__ unsigned pk_fp8x4(float a, float b, float c, float d) { int w = 0; w = __builtin_amdgcn_cvt_pk_fp8_f32(clamp448(a), clamp448(b), w, false); w = __builtin_amdgcn_cvt_pk_fp8_f32(clamp448(c), clamp448(d), w, true); return (unsigned)w; }
constexpr int MOE_H3W = 36, MOE_H3 = MOE_H3W * 8 * 9;
constexpr float WSC = 64.0f, HSC = 8.0f, ASC = 4.0f;
__device__ __forceinline__ float bf_lo(unsigned w) { return __uint_as_float(w << 16); }
__device__ __forceinline__ float bf_hi(unsigned w) { return __uint_as_float(w & 0xffff0000u); }
#define DPP_ADD(v, ctrl) (v) += __builtin_bit_cast(float, __builtin_amdgcn_update_dpp(0, __builtin_bit_cast(int, (v)), (ctrl), 0xf, 0xf, false))
__device__ __forceinline__ float wave_sum(float v) {
    DPP_ADD(v, 0xB1); DPP_ADD(v, 0x4E); DPP_ADD(v, 0x141); DPP_ADD(v, 0x140);
    const int vi = __builtin_bit_cast(int, v);
    const float r0 = __builtin_bit_cast(float, __builtin_amdgcn_readlane(vi, 0)), r1 = __builtin_bit_cast(float, __builtin_amdgcn_readlane(vi, 16)), r2 = __builtin_bit_cast(float, __builtin_amdgcn_readlane(vi, 32)), r3 = __builtin_bit_cast(float, __builtin_amdgcn_readlane(vi, 48));
    return (r0 + r1) + (r2 + r3);
}
__device__ __forceinline__ float fast_exp2(float x) { return __builtin_amdgcn_exp2f(x); }
__device__ __forceinline__ float fast_rcp(float x) { return __builtin_amdgcn_rcpf(x); }
__device__ __forceinline__ float silu_f(float x) { return x * fast_rcp(1.0f + fast_exp2(-x * LOG2E)); }
__device__ __forceinline__ float gelu_tanh(float x) { const float z = x * (1.0f + 0.044715f * x * x) * (-2.0f * 0.7978845608028654f * LOG2E); return x * fast_rcp(1.0f + fast_exp2(z)); }

__device__ __forceinline__ int lane_id() { int l; asm volatile("v_mbcnt_lo_u32_b32 %0, -1, 0\n\tv_mbcnt_hi_u32_b32 %0, -1, %0" : "=v"(l)); return l; }
#define TIDX_OF(wv_) ((wv_) * 64 + lane_id())
#define XB_TMO      128
#define XB_XCNT(j)  (256  + 64 * (j))
#define XB_XSUB(j)  (1280 + 64 * (j))
#define XB_XGEN(j)  (2304 + 64 * (j))
#define XB_TOP      3328
#define XB_TOPGEN   3392
#define XCD_BAR_WORDS 3456
#define XB_SPIN_CAP (1u << 18)
__device__ __forceinline__ unsigned xb_ld(unsigned* p)              { return __hip_atomic_load(p, __ATOMIC_RELAXED, __HIP_MEMORY_SCOPE_AGENT); }
__device__ __forceinline__ unsigned xb_add(unsigned* p, unsigned v) { return __hip_atomic_fetch_add(p, v, __ATOMIC_RELAXED, __HIP_MEMORY_SCOPE_AGENT); }
__device__ __forceinline__ unsigned xb_xcc_id() { return (unsigned)__builtin_amdgcn_s_getreg((3 << 11) | 20) & 0xFu; }
#define XB_SPIN(cond, bar) do { unsigned _sp = 0; while (cond) { __builtin_amdgcn_s_sleep(1); \
    if ((++_sp & 255u) == 0u) { if (xb_ld(&(bar)[XB_TMO])) break; if (_sp > XB_SPIN_CAP) { atomicAdd(&(bar)[XB_TMO], 1u); break; } } } } while (0)
struct XcdBarrier { unsigned* bar; unsigned x; volatile LAS unsigned* st; int wv; };
__device__ __forceinline__ XcdBarrier xcd_barrier_post(unsigned* bar, volatile LAS unsigned* st, int wv) {
    XcdBarrier b; b.bar = bar; b.x = xb_xcc_id(); b.st = st; b.wv = wv;
    if (TIDX_OF(wv) == 0) (void)xb_add(&bar[XB_XCNT(b.x)], 1u);
    return b;
}
__device__ __forceinline__ void xcd_barrier_complete(unsigned* bar, unsigned x, unsigned& nloc, unsigned& nx) {
    const unsigned G = gridDim.x * gridDim.y * gridDim.z;
    unsigned sum, cnt, mine, sp = 0u;
    for (;;) {
        sum = 0u; cnt = 0u; mine = 0u;
#pragma unroll
        for (unsigned j = 0; j < 16; ++j) { const unsigned c = xb_ld(&bar[XB_XCNT(j)]); sum += c; cnt += (c > 0u) ? 1u : 0u; mine = (j == x) ? c : mine; }
        if (sum == G) break;
        __builtin_amdgcn_s_sleep(1);
        if ((++sp & 255u) == 0u) { if (xb_ld(&bar[XB_TMO])) break; if (sp > XB_SPIN_CAP) { atomicAdd(&bar[XB_TMO], 1u); break; } }
    }
    nloc = mine > 0u ? mine : 1u; nx = cnt > 0u ? cnt : 1u;
}
__device__ __forceinline__ void xcd_barrier(const XcdBarrier& b) {
    asm volatile("s_waitcnt vmcnt(0)" ::: "memory");
    __syncthreads();
    if (TIDX_OF(b.wv) == 0) {
        unsigned* bar = b.bar;
        __builtin_amdgcn_s_waitcnt(0);
        unsigned nloc = b.st[0], nx = b.st[1];
        if (nloc == 0u) { xcd_barrier_complete(bar, b.x, nloc, nx); b.st[0] = nloc; b.st[1] = nx; }
        const unsigned old = xb_add(&bar[XB_XSUB(b.x)], 1u);
        const unsigned gen = old / nloc;
        if (old + 1u == (gen + 1u) * nloc) {
            __builtin_amdgcn_fence(__ATOMIC_RELEASE, "agent");
            asm volatile("s_waitcnt vmcnt(0)" ::: "memory");
            const unsigned og = xb_add(&bar[XB_TOP], 1u);
            const unsigned tg = og / nx;
            if (og + 1u == (tg + 1u) * nx) xb_add(&bar[XB_TOPGEN], 1u);
            else XB_SPIN(xb_ld(&bar[XB_TOPGEN]) == tg, bar);
            __builtin_amdgcn_fence(__ATOMIC_ACQUIRE, "agent");
            xb_add(&bar[XB_XGEN(b.x)], 1u);
            asm volatile("s_waitcnt vmcnt(0)" ::: "memory");
        } else {
            XB_SPIN(xb_ld(&bar[XB_XGEN(b.x)]) == gen, bar);
            __builtin_amdgcn_fence(__ATOMIC_ACQUIRE, "agent");
            asm volatile("s_waitcnt vmcnt(0)" ::: "memory");
        }
    }
    __syncthreads();
}

namespace pg8 {
constexpr int BM = 256, BK = 64, HALF = 128, HTB = HALF * BK * 2, STAGE_BYTES = 8 * HTB, NXCD = 8, WGM = 8;
__host__ __device__ __forceinline__ int lds_byte(int r, int c) { const int st = (r >> 4) * 2 + (c >> 5), rr = r & 15, cc = c & 31, ob = rr * 64 + cc * 2; return st * 1024 + (ob ^ (((ob >> 9) & 1) << 5)); }
__host__ __device__ __forceinline__ void stage_rc(int b, int& R, int& C) { const int st = b / 1024, sb = b % 1024, swz = sb ^ (((sb >> 9) & 1) << 5); R = (st >> 1) * 16 + swz / 64; C = (st & 1) * 32 + (swz % 64) / 2; }
__host__ __device__ __forceinline__ int perm32(int rho) { const int n = rho >> 4, i = rho & 15; return 8 * (i >> 2) + 4 * n + (i & 3); }

struct Unit { int pm, pn, e, nv, nt; };
__device__ __forceinline__ void static_unit(int L, int nM, int nN, int& pm, int& pn) {
    const int nwg = nM * nN; int wgid = L;
    { const int q = nwg / NXCD, r = nwg % NXCD, xcd = wgid % NXCD, off = wgid / NXCD; wgid = (xcd < r ? xcd * (q + 1) : r * (q + 1) + (xcd - r) * q) + off; }
    const int nig = WGM * nN, gid = wgid / nig, fm = gid * WGM, gsz = (nM - fm) < WGM ? (nM - fm) : WGM;
    pm = fm + ((wgid % nig) % gsz); pn = (wgid % nig) / gsz;
}

template <class Job, bool ALIGN_EPI>
__device__ __forceinline__ void gemm_phase(LAS unsigned char* lds, const Job& J, const int wv) {
    const int tid = TIDX_OF(wv), wid = __builtin_amdgcn_readfirstlane(tid >> 6), lane = tid & 63, wr = wid >> 2, wc = wid & 3, fr = lane & 15, fq = lane >> 4;
    const int KB = J.KB, ntfull = KB / 128;
    unsigned voffA, voffB;
    { int R, C; stage_rc(tid * 16, R, C); const int Rb = Job::PERM ? ((R & ~31) + perm32(R & 31)) : R; voffA = (unsigned)(R * J.ldab + C * 2); voffB = (unsigned)(Rb * KB + C * 2); }
    const size_t kstep = (size_t)(BK * 2);
    const size_t hstepB = (size_t)HALF * KB, qstepB = (size_t)64 * KB, hstepA = (size_t)HALF * J.ldab, qstepA = (size_t)64 * J.ldab;
    const unsigned ldsw = (unsigned)wid * 1024u;
    const int aoff = lds_byte(wr * 64 + fr, fq * 8), boff = lds_byte(wc * 32 + fr, fq * 8);
#define PG8_SA(b, h) (((b) * 2 + (h)) * HTB)
#define PG8_SB(b, h) ((4 + (b) * 2 + (h)) * HTB)
#define PG8_STAGE_X(bufoff, gbase, voff, qstep) do { unsigned _v = (voff), _w = (voff); asm volatile("" : "+v"(_v)); asm volatile("" : "+v"(_w));     \
        const char* _g0 = (const char*)(gbase); const char* _g1 = _g0 + (qstep); asm volatile("" : "+s"(_g1)); \
        __builtin_amdgcn_global_load_lds((const unsigned*)(_g0 + _v), (LAS unsigned*)(lds + (bufoff) + ldsw), 16, 0, 0); \
        __builtin_amdgcn_global_load_lds((const unsigned*)(_g1 + _w), (LAS unsigned*)(lds + (bufoff) + ldsw + 8192), 16, 0, 0); } while (0)
#define PG8_STAGE_B(bufoff, gbase) PG8_STAGE_X(bufoff, gbase, voffB, qstepB)
#define PG8_STAGE_A(bufoff, gbase, h) PG8_STAGE_X(bufoff, (gbase) + (h) * hstepA, voffA, qstepA)
#define PG8_LDA(dst, b, h) do { _Pragma("unroll") for (int m = 0; m < 4; ++m) _Pragma("unroll") for (int k = 0; k < 2; ++k) dst[m][k] = *(const LAS bf16x8*)(lds + PG8_SA(b, h) + aoff + m * 2048 + k * 1024); } while (0)
#define PG8_LDB(dst, b, h) do { _Pragma("unroll") for (int n = 0; n < 2; ++n) _Pragma("unroll") for (int k = 0; k < 2; ++k) dst[n][k] = *(const LAS bf16x8*)(lds + PG8_SB(b, h) + boff + n * 2048 + k * 1024); } while (0)
#define PG8_CAT(x) __builtin_shufflevector(__builtin_bit_cast(i32x4, (x)[0]), __builtin_bit_cast(i32x4, (x)[1]), 0, 1, 2, 3, 4, 5, 6, 7)
#define PG8_MMA(ai, bj, At, Bt) do { __builtin_amdgcn_s_setprio(1); if constexpr (Job::FP8) { _Pragma("unroll") for (int m = 0; m < 4; ++m) _Pragma("unroll") for (int n = 0; n < 2; ++n) \
        acc[ai][bj][m][n] = __builtin_amdgcn_mfma_scale_f32_16x16x128_f8f6f4(PG8_CAT(Bt[n]), PG8_CAT(At[m]), acc[ai][bj][m][n], 0, 0, 0, 0, 0, 0); } else { \
        _Pragma("unroll") for (int m = 0; m < 4; ++m) _Pragma("unroll") for (int n = 0; n < 2; ++n) _Pragma("unroll") for (int k = 0; k < 2; ++k) \
        acc[ai][bj][m][n] = __builtin_amdgcn_mfma_f32_16x16x32_bf16(Bt[n][k], At[m][k], acc[ai][bj][m][n], 0, 0, 0); } __builtin_amdgcn_s_setprio(0); } while (0)
#define PG8_WAIT_V(n) asm volatile("s_waitcnt vmcnt(" #n ")" ::: "memory")
#define PG8_WAIT_L(n) asm volatile("s_waitcnt lgkmcnt(" #n ")" ::: "memory")
#define PG8_BAR __builtin_amdgcn_s_barrier()
#define PG8_SCHED __builtin_amdgcn_sched_barrier(0)
    Unit cur, nxt; int ui = 0; cur.nt = 0; nxt.nt = 0;
    if (!J.next(0, cur)) return;
    int nt = cur.nt ? cur.nt : ntfull;
    f32x4 acc[2][2][4][2];
#pragma unroll
    for (int a = 0; a < 2; ++a)
#pragma unroll
        for (int b = 0; b < 2; ++b)
#pragma unroll
            for (int m = 0; m < 4; ++m)
#pragma unroll
                for (int n = 0; n < 2; ++n) acc[a][b][m][n] = (f32x4){0.f, 0.f, 0.f, 0.f};
    bf16x8 At[4][2], B0[2][2], B1[2][2];
    const char* cA = J.a_ptr(cur); const char* cB = J.b_ptr(cur);
    PG8_STAGE_B(PG8_SB(0, 0), cB); PG8_STAGE_B(PG8_SB(0, 1), cB + hstepB); PG8_STAGE_A(PG8_SA(0, 0), cA, 0); PG8_STAGE_A(PG8_SA(0, 1), cA, 1);
    if (wr == 1) PG8_BAR;
    PG8_WAIT_V(2); PG8_BAR;
    PG8_STAGE_B(PG8_SB(1, 0), cB + kstep); PG8_STAGE_A(PG8_SA(1, 0), cA + kstep, 0); PG8_STAGE_B(PG8_SB(1, 1), cB + hstepB + kstep);
    PG8_WAIT_V(6); PG8_BAR;
    for (;;) {
        nxt.nt = 0; const bool has_next = J.next(ui + 1, nxt);
        const char* nA = cA; const char* nB = cB;
        if (has_next) { nA = J.a_ptr(nxt); nB = J.b_ptr(nxt); }
        for (int t = 0; t < nt; t += 2) {
            const bool last = (t == nt - 2);
            const char* a1 = cA + (size_t)(t + 1) * kstep;
            const char* a2 = last ? nA : cA + (size_t)(t + 2) * kstep; const char* b2 = last ? nB : cB + (size_t)(t + 2) * kstep;
            const char* a3 = a2 + kstep; const char* b3 = b2 + kstep;
            PG8_LDB(B0, 0, 0); PG8_LDB(B1, 0, 1); PG8_SCHED; PG8_LDA(At, 0, 0); PG8_STAGE_A(PG8_SA(1, 1), a1, 1);
            PG8_WAIT_V(8); PG8_WAIT_L(0); PG8_BAR; PG8_MMA(0, 0, At, B0); PG8_MMA(0, 1, At, B1); PG8_BAR; PG8_SCHED;
            PG8_LDA(At, 0, 1); PG8_STAGE_B(PG8_SB(0, 0), b2); PG8_STAGE_B(PG8_SB(0, 1), b2 + hstepB); PG8_STAGE_A(PG8_SA(0, 0), a2, 0);
            PG8_WAIT_V(8); PG8_WAIT_L(0); PG8_BAR; PG8_MMA(1, 0, At, B0); PG8_MMA(1, 1, At, B1); PG8_BAR; PG8_SCHED;
            PG8_LDB(B0, 1, 0); PG8_LDB(B1, 1, 1); PG8_SCHED; PG8_LDA(At, 1, 0); PG8_STAGE_A(PG8_SA(0, 1), a2, 1);
            PG8_WAIT_V(8); PG8_WAIT_L(0); PG8_BAR; PG8_MMA(0, 0, At, B0); PG8_MMA(0, 1, At, B1); PG8_BAR; PG8_SCHED;
            PG8_LDA(At, 1, 1); PG8_STAGE_B(PG8_SB(1, 0), b3); PG8_STAGE_B(PG8_SB(1, 1), b3 + hstepB); PG8_STAGE_A(PG8_SA(1, 0), a3, 0);
            PG8_WAIT_V(8); PG8_WAIT_L(0); PG8_BAR; PG8_MMA(1, 0, At, B0); PG8_MMA(1, 1, At, B1); PG8_BAR; PG8_SCHED;
        }
        if constexpr (ALIGN_EPI) { if (wr == 0) PG8_BAR; }
        { int l2 = lane_id(); asm volatile("" : "+v"(l2));
          J.epi(acc, cur, wr, wc, l2 & 15, l2 >> 4); }
        if (!has_next) break;
#pragma unroll
        for (int a = 0; a < 2; ++a)
#pragma unroll
            for (int b = 0; b < 2; ++b)
#pragma unroll
                for (int m = 0; m < 4; ++m)
#pragma unroll
                    for (int n = 0; n < 2; ++n) acc[a][b][m][n] = (f32x4){0.f, 0.f, 0.f, 0.f};
        cur = nxt; cA = nA; cB = nB; ++ui; nt = cur.nt ? cur.nt : ntfull;
        if constexpr (ALIGN_EPI) { if (wr == 1) PG8_BAR; }
    }
    PG8_WAIT_V(0);
    if constexpr (!ALIGN_EPI) { if (wr == 0) PG8_BAR; }
    PG8_BAR;
#undef PG8_SA
#undef PG8_SB
#undef PG8_STAGE_A
#undef PG8_STAGE_B
#undef PG8_STAGE_X
#undef PG8_LDA
#undef PG8_LDB
#undef PG8_MMA
#undef PG8_CAT
#undef PG8_WAIT_V
#undef PG8_WAIT_L
#undef PG8_BAR
#undef PG8_SCHED
}
}
using pg8::Unit;

__device__ __forceinline__ f32x4 swiglu4(f32x4 g, f32x4 u, float c1, float c2) {
    const f32x4 t = g * c1; f32x4 e = (f32x4){fast_exp2(t[0]), fast_exp2(t[1]), fast_exp2(t[2]), fast_exp2(t[3])}; e = e + 1.0f;
    const f32x4 r = (f32x4){fast_rcp(e[0]), fast_rcp(e[1]), fast_rcp(e[2]), fast_rcp(e[3])};
    return ((g * u) * r) * c2;
}
__device__ __forceinline__ void st_bf4(bf16_t* p, f32x4 v) { u32x2 w; w.x = cvt_pk_bf16(v[0], v[1]); w.y = cvt_pk_bf16(v[2], v[3]); *(u32x2*)p = w; }
__device__ __forceinline__ void st_f8x8(unsigned char* p, f32x4 v0, f32x4 v1) { u32x2 w; w.x = pk_fp8x4(v0[0], v0[1], v0[2], v0[3]); w.y = pk_fp8x4(v1[0], v1[1], v1[2], v1[3]); *(u32x2*)p = w; }
__device__ __forceinline__ void st_bf8(bf16_t* p, f32x4 v0, f32x4 v1) { u32x4 w; w.x = cvt_pk_bf16(v0[0], v0[1]); w.y = cvt_pk_bf16(v0[2], v0[3]); w.z = cvt_pk_bf16(v1[0], v1[1]); w.w = cvt_pk_bf16(v1[2], v1[3]); *(u32x4*)p = w; }


struct JobProj {
    static constexpr bool PERM = false, FP8 = false;
    int KB, ldab, G, c, NT = 0; const bf16_t *H, *WT; bf16_t *PROJ, *KVC; const float* rope; float* ssq;
    __device__ __forceinline__ bool next(int i, Unit& u) const {
        const int L = i * G + c;
        if (L < 448) { pg8::static_unit(L, 64, 7, u.pm, u.pn); u.e = 0; u.nv = 256; return true; }
        if (L < 452) { u.pm = L - 448; u.pn = 2; u.e = 1; u.nv = 256; return true; }
        return false;
    }
    __device__ __forceinline__ const char* a_ptr(const Unit& u) const { return (const char*)H + (ptrdiff_t)u.e * ((ptrdiff_t)WS_HC - (ptrdiff_t)WS_H) + (size_t)u.pm * 256 * DM * 2; }
    __device__ __forceinline__ const char* b_ptr(const Unit& u) const { return (const char*)WT + (size_t)u.pn * 256 * DM * 2; }
    __device__ __forceinline__ void epi(const f32x4 (&acc)[2][2][4][2], const Unit& u, int wr, int wc, int fr, int fq) const {
        const int row0 = u.pm * 256 + wr * 64 + fr;
        if (u.e == 1) {
#pragma unroll
            for (int ai = 0; ai < 2; ++ai)
#pragma unroll
                for (int m = 0; m < 4; ++m) { bf16_t* rp = KVC + (size_t)(row0 + ai * 128 + m * 16) * 256 + wc * 32 + 4 * fq;
#pragma unroll
                    for (int bj = 0; bj < 2; ++bj)
#pragma unroll
                        for (int n = 0; n < 2; ++n) st_bf4(rp + bj * 128 + n * 16, acc[ai][bj][m][n]); }
        } else if (u.pn <= 2) {
            const float qs = u.pn < 2 ? QSCALE : 1.0f;
#pragma unroll
            for (int ai = 0; ai < 2; ++ai)
#pragma unroll
                for (int m = 0; m < 4; ++m) { const int row = row0 + ai * 128 + m * 16, t = row & (SEQ - 1), pos = (wc & 1) ? (t & 63) : (t >> 6);
                    const f32x4 cs0 = *(const f32x4*)(rope + (pos * 16 + 4 * fq) * 2), cs1 = *(const f32x4*)(rope + (pos * 16 + 4 * fq) * 2 + 4);
                    const f32x4 cv = (f32x4){cs0[0], cs0[2], cs1[0], cs1[2]}, sv = (f32x4){cs0[1], cs0[3], cs1[1], cs1[3]};
                    bf16_t* rp = PROJ + (size_t)row * INW + u.pn * 256 + wc * 32 + 4 * fq;
#pragma unroll
                    for (int bj = 0; bj < 2; ++bj) { const f32x4 v1 = acc[ai][bj][m][0], v2 = acc[ai][bj][m][1]; f32x4 o1, o2;
                        if (u.pn < 2 || bj == 0) { o1 = (v1 * cv - v2 * sv) * qs; o2 = (v2 * cv + v1 * sv) * qs; } else { o1 = v1; o2 = v2; }
                        st_bf4(rp + bj * 128, o1); st_bf4(rp + bj * 128 + 16, o2); } }
        } else {
#pragma unroll
            for (int ai = 0; ai < 2; ++ai)
#pragma unroll
                for (int m = 0; m < 4; ++m) { const int row = row0 + ai * 128 + m * 16; bf16_t* rp = PROJ + (size_t)row * INW + u.pn * 256 + wc * 32 + 4 * fq; float ss = 0.f;
#pragma unroll
                    for (int bj = 0; bj < 2; ++bj)
#pragma unroll
                        for (int n = 0; n < 2; ++n) { const f32x4 v = acc[ai][bj][m][n]; const f32x4 ge = (f32x4){gelu_tanh(v[0]), gelu_tanh(v[1]), gelu_tanh(v[2]), gelu_tanh(v[3])};
                            ss += (ge[0] * ge[0] + ge[1] * ge[1]) + (ge[2] * ge[2] + ge[3] * ge[3]); st_bf4(rp + bj * 128 + n * 16, ge); }
                    if (u.pn >= 5) { ss += __shfl_xor(ss, 16); ss += __shfl_xor(ss, 32); if (fq == 0) ssq[(size_t)row * 8 + (u.pn - 5) * 4 + wc] = ss; } }
        }
    }
};

template <bool F8, bool XF32> struct JobRes {
    static constexpr bool PERM = true, FP8 = F8;
    int KB, ldab, G, c, pool, NT = 0; float ascale; const void *A, *Bt; const void* xin; bf16_t* xout; const float* gate; const float* cscale; float* ssq2;
    __device__ __forceinline__ bool next(int i, Unit& u) const { const int L = i * G + c; if (L >= 256) return false; pg8::static_unit(L, 64, 4, u.pm, u.pn); u.e = 0; u.nv = 256; return true; }
    __device__ __forceinline__ const char* a_ptr(const Unit& u) const { return (const char*)A + (size_t)u.pm * 256 * ldab + (pool ? u.pn * 512 : 0); }
    __device__ __forceinline__ const char* b_ptr(const Unit& u) const { return (const char*)Bt + (size_t)u.pn * 256 * KB; }
    __device__ __forceinline__ void epi(const f32x4 (&acc)[2][2][4][2], const Unit& u, int wr, int wc, int fr, int fq) const {
        const int b = u.pm >> 4, col0 = u.pn * 256 + wc * 32 + 8 * fq; const float* g = gate + (size_t)b * 6144 + col0;
        f32x4 gv[2][2];
#pragma unroll
        for (int bj = 0; bj < 2; ++bj)
#pragma unroll
            for (int n = 0; n < 2; ++n) { gv[bj][n] = *(const f32x4*)(g + bj * 128 + n * 4) * ascale; if (cscale) gv[bj][n] = gv[bj][n] * *(const f32x4*)(cscale + col0 + bj * 128 + n * 4); }
#pragma unroll
        for (int ai = 0; ai < 2; ++ai)
#pragma unroll
            for (int m = 0; m < 4; ++m) { const int row = u.pm * 256 + ai * 128 + wr * 64 + m * 16 + fr; const size_t off = (size_t)row * DM + col0; float ss = 0.f;
#pragma unroll
                for (int bj = 0; bj < 2; ++bj) { f32x4 x0, x1;
                    if constexpr (XF32) { x0 = *(const f32x4*)((const float*)xin + off + bj * 128); x1 = *(const f32x4*)((const float*)xin + off + bj * 128 + 4); }
                    else { const u32x4 w = *(const u32x4*)((const bf16_t*)xin + off + bj * 128); x0 = (f32x4){bf_lo(w.x), bf_hi(w.x), bf_lo(w.y), bf_hi(w.y)}; x1 = (f32x4){bf_lo(w.z), bf_hi(w.z), bf_lo(w.w), bf_hi(w.w)}; }
                    const f32x4 o0 = x0 + gv[bj][0] * acc[ai][bj][m][0], o1 = x1 + gv[bj][1] * acc[ai][bj][m][1];
                    st_bf8(xout + off + bj * 128, o0, o1);
                    ss += ((o0[0] * o0[0] + o0[1] * o0[1]) + (o0[2] * o0[2] + o0[3] * o0[3])) + ((o1[0] * o1[0] + o1[1] * o1[1]) + (o1[2] * o1[2] + o1[3] * o1[3])); }
                if (ssq2) ssq2[(size_t)row * 64 + u.pn * 16 + wc * 4 + fq] = ss; }
    }
};

struct JobGU {
    static constexpr bool PERM = true, FP8 = false;
    int KB, ldab, G, c, NT = 0; const bf16_t *H, *WT; unsigned char* ACT;
    __device__ __forceinline__ bool next(int i, Unit& u) const { const int L = i * G + c; if (L >= 64 * 22) return false; pg8::static_unit(L, 64, 22, u.pm, u.pn); u.e = 0; u.nv = 256; return true; }
    __device__ __forceinline__ const char* a_ptr(const Unit& u) const { return (const char*)H + (size_t)u.pm * 256 * DM * 2; }
    __device__ __forceinline__ const char* b_ptr(const Unit& u) const { return (const char*)WT + (size_t)u.pn * 256 * DM * 2; }
    __device__ __forceinline__ void epi(const f32x4 (&acc)[2][2][4][2], const Unit& u, int wr, int wc, int fr, int fq) const {
#pragma unroll
        for (int ai = 0; ai < 2; ++ai)
#pragma unroll
            for (int m = 0; m < 4; ++m) { unsigned char* rp = ACT + (size_t)(u.pm * 256 + ai * 128 + wr * 64 + m * 16 + fr) * FFD + u.pn * 128 + wc * 32 + 8 * fq;
                f32x4 o[2];
#pragma unroll
                for (int n = 0; n < 2; ++n) o[n] = swiglu4(acc[ai][0][m][n], acc[ai][1][m][n], -LOG2E, ASC);
                st_f8x8(rp, o[0], o[1]); asm volatile("" ::: "memory"); }
    }
};

struct MoeTiles {
    int p1, p2, p3, p4, p5, p6, p7, p8;
    __device__ __forceinline__ void init(const int* tot) {
        int s = 0;
#define MT_STEP(k, dst) s += ((int)__builtin_amdgcn_readfirstlane(tot[k]) + 255) >> 8; dst = s;
        MT_STEP(0, p1) MT_STEP(1, p2) MT_STEP(2, p3) MT_STEP(3, p4) MT_STEP(4, p5) MT_STEP(5, p6) MT_STEP(6, p7) MT_STEP(7, p8)
#undef MT_STEP
    }
    __device__ __forceinline__ int expert_of(int rt) const { int e = 0; e = rt >= p1 ? 1 : e; e = rt >= p2 ? 2 : e; e = rt >= p3 ? 3 : e; e = rt >= p4 ? 4 : e; e = rt >= p5 ? 5 : e; e = rt >= p6 ? 6 : e; e = rt >= p7 ? 7 : e; return __builtin_amdgcn_readfirstlane(e); }
};
__device__ __forceinline__ int moe_gu_groups(int ntiles, int G) { if (G != 256) return G; const int units = ntiles * 28, rounds = (units + 255) >> 8; if (rounds == 0) return G; int gp = (units + rounds - 1) / rounds; gp = gp < 247 ? 247 : gp; return gp > G ? G : gp; }
__device__ __forceinline__ int moe_h3_quota(int nh) { const int q = MOE_H3W * 8 * nh; return q > MOE_H3 ? MOE_H3 : q; }
__device__ __forceinline__ int moe_nsplit(int ntiles, int G) { const int n = (G == 256 && ntiles > 128) ? ntiles - 128 : 0; return n > 8 ? 8 : n; }
struct JobMGU {
    static constexpr bool PERM = true, FP8 = true;
    int KB, ldab, G, c, NT = 0; MoeTiles T; const unsigned char *XS, *WT; unsigned char* ACT;
    __device__ __forceinline__ bool next(int i, Unit& u) const { const int L = i * G + c; if (L >= T.p8 * 28) return false; pg8::static_unit(L, T.p8, 28, u.pm, u.pn); u.e = T.expert_of(u.pm); u.nv = 256; return true; }
    __device__ __forceinline__ const char* a_ptr(const Unit& u) const { return (const char*)XS + (size_t)u.pm * 256 * DM; }
    __device__ __forceinline__ const char* b_ptr(const Unit& u) const { return (const char*)WT + ((size_t)u.e * 7168 + (size_t)u.pn * 256) * DM; }
    __device__ __forceinline__ void epi(const f32x4 (&acc)[2][2][4][2], const Unit& u, int wr, int wc, int fr, int fq) const {
#pragma unroll
        for (int ai = 0; ai < 2; ++ai)
#pragma unroll
            for (int m = 0; m < 4; ++m) { unsigned char* rp = ACT + (size_t)(u.pm * 256 + ai * 128 + wr * 64 + m * 16 + fr) * FFE + u.pn * 128 + wc * 32 + 8 * fq;
                f32x4 o[2];
#pragma unroll
                for (int n = 0; n < 2; ++n) o[n] = swiglu4(acc[ai][0][m][n], acc[ai][1][m][n], -LOG2E / (WSC * HSC), ASC / ((WSC * HSC) * (WSC * HSC)));
                st_f8x8(rp, o[0], o[1]); asm volatile("" ::: "memory"); }
    }
};
struct JobMDown {
    static constexpr bool PERM = true, FP8 = true;
    int KB, ldab, G, c, NT = 0; MoeTiles T; const unsigned char *ACT, *WT; bf16_t *Y, *YS;
    int nfull, nsplit;
    __device__ __forceinline__ bool next(int i, Unit& u) const { const int L = i * G + c, nf = nfull * 4;
        if (L < nf) { pg8::static_unit(L, nfull, 4, u.pm, u.pn); u.nv = -1; u.nt = 0; }
        else { const int Ls = L - nf; if (Ls >= nsplit * 28) return false; const int q = Ls / 7; u.nv = Ls - q * 7; u.pn = q & 3; u.pm = nfull + (q >> 2); u.nt = 4; }
        u.e = T.expert_of(u.pm); return true; }
    __device__ __forceinline__ const char* a_ptr(const Unit& u) const { return (const char*)ACT + (size_t)u.pm * 256 * FFE + (u.nv < 0 ? 0 : u.nv * 512); }
    __device__ __forceinline__ const char* b_ptr(const Unit& u) const { return (const char*)WT + ((size_t)u.e * DM + (size_t)u.pn * 256) * FFE + (u.nv < 0 ? 0 : u.nv * 512); }
    __device__ __forceinline__ void epi(const f32x4 (&acc)[2][2][4][2], const Unit& u, int wr, int wc, int fr, int fq) const {
        bf16_t* base = (bf16_t*)((char*)Y + (u.nv < 0 ? (ptrdiff_t)0 : (ptrdiff_t)((char*)YS - (char*)Y))) + (u.nv < 0 ? (size_t)u.pm : (size_t)u.nv * 8 + (u.pm - nfull)) * 256 * DM;
#pragma unroll
        for (int ai = 0; ai < 2; ++ai)
#pragma unroll
            for (int m = 0; m < 4; ++m) { bf16_t* rp = base + (size_t)(ai * 128 + wr * 64 + m * 16 + fr) * DM + u.pn * 256 + wc * 32 + 8 * fq;
#pragma unroll
                for (int bj = 0; bj < 2; ++bj) st_bf8(rp + bj * 128, acc[ai][bj][m][0] * (1.0f / (WSC * ASC)), acc[ai][bj][m][1] * (1.0f / (WSC * ASC))); asm volatile("" ::: "memory"); }
    }
};

struct Args { const float* in[22]; float* out; unsigned char* ws; int ph_lo, ph_hi; int wv, pad; };
enum { I_X = 0, I_C, I_CTX, I_CCTX, I_WADA, I_BADA, I_WIN, I_SINK, I_GMGAIN, I_GMWS, I_GMBS, I_WOUT, I_FG, I_FU, I_FD, I_PW, I_PSC, I_RW, I_MG, I_MU, I_MD, I_FGAIN };

__device__ __forceinline__ void tr_item(const float* W, int K, int N, bf16_t* WT, int mode, int item, LAS float* scr, int lane) {
    const int nblk = N >> 5, kb = item / nblk, nb = item - kb * nblk, k0 = kb * 64, n0 = nb * 32;
    const int drow0 = mode == 0 ? n0 : (((n0 >> 7) << 8) + (n0 & 127) + (mode == 2 ? 128 : 0));
    float ld[32];
#pragma unroll
    for (int i = 0; i < 32; ++i) ld[i] = W[(size_t)(k0 + 2 * i + (lane >> 5)) * N + n0 + (lane & 31)];
#pragma unroll
    for (int i = 0; i < 32; ++i) scr[(2 * i + (lane >> 5)) * 33 + (lane & 31)] = ld[i];
    LDS_WAIT();
    const int c = lane & 7;
#pragma unroll
    for (int j = 0; j < 4; ++j) { const int n = (lane >> 3) + 8 * j; const LAS float* s = scr + (8 * c) * 33 + n;
        u32x4 o; o.x = cvt_pk_bf16(s[0 * 33], s[1 * 33]); o.y = cvt_pk_bf16(s[2 * 33], s[3 * 33]); o.z = cvt_pk_bf16(s[4 * 33], s[5 * 33]); o.w = cvt_pk_bf16(s[6 * 33], s[7 * 33]);
        *(u32x4*)(WT + (size_t)(drow0 + n) * K + k0 + 8 * c) = o; }
    LDS_WAIT();
}
__device__ __forceinline__ void tr_item8(const float* W, int K, int N, unsigned char* WT, int mode, int item, LAS float* scr, int lane) {
    const int nblk = N >> 5, kb = item / nblk, nb = item - kb * nblk, k0 = kb * 128, n0 = nb * 32;
    const int drow0 = mode == 0 ? n0 : (((n0 >> 7) << 8) + (n0 & 127) + (mode == 2 ? 128 : 0));
#pragma unroll
    for (int hb = 0; hb < 2; ++hb) { float ld[32];
#pragma unroll
        for (int i = 0; i < 32; ++i) ld[i] = W[(size_t)(k0 + 64 * hb + 2 * i + (lane >> 5)) * N + n0 + (lane & 31)];
#pragma unroll
        for (int i = 0; i < 32; ++i) scr[(64 * hb + 2 * i + (lane >> 5)) * 33 + (lane & 31)] = ld[i]; }
    LDS_WAIT();
    const int c = lane & 15;
#pragma unroll
    for (int j = 0; j < 8; ++j) { const int n = (lane >> 4) + 4 * j; const LAS float* s = scr + (8 * c) * 33 + n;
        u32x2 o; o.x = pk_fp8x4(s[0 * 33] * WSC, s[1 * 33] * WSC, s[2 * 33] * WSC, s[3 * 33] * WSC); o.y = pk_fp8x4(s[4 * 33] * WSC, s[5 * 33] * WSC, s[6 * 33] * WSC, s[7 * 33] * WSC);
        *(u32x2*)(WT + (size_t)(drow0 + n) * K + k0 + 8 * c) = o; }
    LDS_WAIT();
}
__device__ __forceinline__ void ada_task(const float* c, const float* cctx, const float* w_ada, float* part, int task, int lane) {
    const int l = task / 768, rem = task - l * 768, cb = rem >> 5, kc = rem & 31;
    const int kk = kc * 32 + (lane & 31);
    float sv[5];
#pragma unroll
    for (int b = 0; b < 4; ++b) { const float v = c[b * DM + kk]; sv[b] = v / (1.0f + __expf(-v)); }
    { const float v = cctx[kk]; sv[4] = v / (1.0f + __expf(-v)); }
    const float* wp = w_ada + ((size_t)l * DM + kc * 32) * 6144 + cb * 256 + lane * 4;
    f32x4 acc[5];
#pragma unroll
    for (int b = 0; b < 5; ++b) acc[b] = (f32x4){0.f, 0.f, 0.f, 0.f};
#pragma unroll
    for (int k = 0; k < 32; ++k) { const f32x4 w = *(const f32x4*)(wp + (size_t)k * 6144);
#pragma unroll
        for (int b = 0; b < 5; ++b) { const float s = __shfl(sv[b], k); acc[b] = acc[b] + w * s; } }
#pragma unroll
    for (int b = 0; b < 5; ++b) *(f32x4*)(part + (((size_t)(l * 32 + kc) * 5 + b) * 6144 + cb * 256 + lane * 4)) = acc[b];
}
constexpr int MOE_I = 8 * 112, NMOE = 8 * 3 * MOE_I;
struct TrDesc { const float* src; unsigned char* dst; int N, K; };
__device__ __forceinline__ TrDesc moe_desc(const Args& a, int m) {
    unsigned char* ws = a.ws; const float* W; unsigned char* WT; int K, N, mode, q;
    if (m < 16 * MOE_I) { const int e = m / (2 * MOE_I); q = m - e * (2 * MOE_I); WT = ws + WS_WMGU + (size_t)e * 7168 * DM; K = DM; N = FFE;
        if (q < MOE_I) { W = a.in[I_MG] + (size_t)e * DM * FFE; mode = 1; } else { q -= MOE_I; W = a.in[I_MU] + (size_t)e * DM * FFE; mode = 2; } }
    else { const int md = m - 16 * MOE_I, e = md / MOE_I; q = md - e * MOE_I; W = a.in[I_MD] + (size_t)e * FFE * DM; WT = ws + WS_WMDN + (size_t)e * DM * FFE; K = FFE; N = DM; mode = 0; }
    const int nblk = N >> 5, kb = q / nblk, nb = q - kb * nblk, k0 = kb * 128, n0 = nb * 32;
    const int drow0 = mode == 0 ? n0 : (((n0 >> 7) << 8) + (n0 & 127) + (mode == 2 ? 128 : 0));
    TrDesc d; d.src = W + (size_t)k0 * N + n0; d.dst = WT + (size_t)drow0 * K + k0; d.N = N; d.K = K; return d;
}
__device__ __forceinline__ void tr8_load(const TrDesc& d, int hb, float (&ld)[32], int lane) {
    const float* p = d.src + (size_t)(64 * hb + (lane >> 5)) * d.N + (lane & 31);
#pragma unroll
    for (int i = 0; i < 32; ++i) ld[i] = __builtin_nontemporal_load(p + (size_t)(2 * i) * d.N);
}
__device__ __forceinline__ void tr8_tolds(int hb, const float (&ld)[32], LAS float* scr, int lane) {
#pragma unroll
    for (int i = 0; i < 32; ++i) scr[(64 * hb + 2 * i + (lane >> 5)) * 33 + (lane & 31)] = ld[i];
}
__device__ __forceinline__ void tr8_out(const TrDesc& d, LAS float* scr, int lane) {
    LDS_WAIT();
    const int c = lane & 15;
#pragma unroll
    for (int j = 0; j < 8; ++j) { const int n = (lane >> 4) + 4 * j; const LAS float* s = scr + (8 * c) * 33 + n;
        u32x2 o; o.x = pk_fp8x4(s[0 * 33] * WSC, s[1 * 33] * WSC, s[2 * 33] * WSC, s[3 * 33] * WSC); o.y = pk_fp8x4(s[4 * 33] * WSC, s[5 * 33] * WSC, s[6 * 33] * WSC, s[7 * 33] * WSC);
        *(u32x2*)(d.dst + (size_t)n * d.K + 8 * c) = o; }
    LDS_WAIT();
}
__device__ __forceinline__ void moe_stream(const Args& a, LAS float* scr, int m0, int hi, int stride, int lane) {
    if (m0 >= hi) return;
    float la[32], lb[32];
    TrDesc d = moe_desc(a, m0); tr8_load(d, 0, la, lane); tr8_load(d, 1, lb, lane);
    for (int m = m0; m < hi; m += stride) {
        const bool hn = m + stride < hi; TrDesc dn = d; if (hn) dn = moe_desc(a, m + stride);
        tr8_tolds(0, la, scr, lane); if (hn) tr8_load(dn, 0, la, lane);
        tr8_tolds(1, lb, scr, lane); if (hn) tr8_load(dn, 1, lb, lane);
        tr8_out(d, scr, lane);
        d = dn;
    }
}
__device__ __forceinline__ void moe_convert_range(const Args& a, LAS unsigned char* lds, int lo, int hi, int hc, int nh) {
    const int lane = lane_id(), wave = a.wv;
    moe_stream(a, (LAS float*)(lds + wave * 16896), lo + hc * 8 + wave, hi, nh * 8, lane);
}
constexpr int GP_PROJ = 226, GP_GU = 235;
constexpr int MOE_H1 = 10 * 8 * (256 - GP_PROJ), MOE_H2 = 32 * 8 * (256 - GP_GU);
constexpr int MOE_X0 = NMOE - MOE_H1 - MOE_H2 - MOE_H3, MOE_X1 = MOE_X0 + MOE_H1, MOE_X2 = MOE_X1 + MOE_H2;
__device__ __forceinline__ void ada_block_task(const Args& a, LAS unsigned char* lds, int t, int wave, int lane) {
    const int l = t / 96, j0 = (t - l * 96) * 64;
    float sv[5][2];
#pragma unroll
    for (int b = 0; b < 5; ++b)
#pragma unroll
        for (int h = 0; h < 2; ++h) { const float v = b < 4 ? a.in[I_C][b * DM + 128 * wave + 64 * h + lane] : a.in[I_CCTX][128 * wave + 64 * h + lane]; sv[b][h] = v / (1.0f + __expf(-v)); }
    const float* wp = a.in[I_WADA] + ((size_t)l * DM + 128 * wave) * 6144 + j0 + lane;
    float acc[5] = {0.f, 0.f, 0.f, 0.f, 0.f};
#pragma unroll
    for (int kb = 0; kb < 4; ++kb) { float wv_[32];
#pragma unroll
        for (int k = 0; k < 32; ++k) wv_[k] = wp[(size_t)(32 * kb + k) * 6144];
#pragma unroll
        for (int k = 0; k < 32; ++k) { const int kk = 32 * kb + k;
#pragma unroll
            for (int b = 0; b < 5; ++b) acc[b] += __shfl(sv[b][kk >> 6], kk & 63) * wv_[k]; } }
    LAS float* red = (LAS float*)lds;
#pragma unroll
    for (int b = 0; b < 5; ++b) red[(wave * 5 + b) * 64 + lane] = acc[b];
    __syncthreads();
    if (wave < 5) { float sum = a.in[I_BADA][l * 6144 + j0 + lane];
#pragma unroll
        for (int w = 0; w < 8; ++w) sum += red[(w * 5 + wave) * 64 + lane];
        ((float*)(a.ws + WS_MOD))[(size_t)(l * 5 + wave) * 6144 + j0 + lane] = sum; }
    __syncthreads();
}
__device__ __forceinline__ void p0_prologue(const Args& a, LAS unsigned char* lds, int G) {
    const int tid = TIDX_OF(a.wv), lane = tid & 63, wave = a.wv;
    LAS float* scr = (LAS float*)(lds + wave * 16896);
    const int gw = blockIdx.x * 8 + wave, NGW = G * 8;
    unsigned char* ws = a.ws;
    for (int idx = blockIdx.x * 512 + tid; idx < 1024; idx += G * 512) { const int pos = idx >> 4, i = idx & 15;
        const float inv = exp2f(-(float)i * (13.287712379549449f / 16.0f));
        const float ang = (float)pos * inv; float sn, cs; sn = sinf(ang); cs = cosf(ang);
        ((float*)(ws + WS_ROPE))[idx * 2] = cs; ((float*)(ws + WS_ROPE))[idx * 2 + 1] = sn; }
    constexpr int N_ADA = 0, N_ADA_BLK = 192;
    for (int t = blockIdx.x; t < N_ADA_BLK; t += G) ada_block_task(a, lds, t, wave, lane);
    constexpr int I_IN = 16 * 56, I_OUT = 16 * 32, I_F = 16 * 88, I_FDN = 22 * 32, I_PWI = 4 * 32;
    constexpr int NITEMS = N_ADA + I_IN + I_OUT + 2 * I_F + I_FDN + I_PWI;
    for (int it = gw; it < NITEMS; it += NGW) {
        int r = it;
        if (r < I_IN) { tr_item(a.in[I_WIN], DM, INW, (bf16_t*)(ws + WS_WIN), 0, r, scr, lane); continue; } r -= I_IN;
        if (r < I_OUT) { tr_item(a.in[I_WOUT], DM, DM, (bf16_t*)(ws + WS_WOUT), 0, r, scr, lane); continue; } r -= I_OUT;
        if (r < I_F) { tr_item(a.in[I_FG], DM, FFD, (bf16_t*)(ws + WS_WGU), 1, r, scr, lane); continue; } r -= I_F;
        if (r < I_F) { tr_item(a.in[I_FU], DM, FFD, (bf16_t*)(ws + WS_WGU), 2, r, scr, lane); continue; } r -= I_F;
        if (r < I_FDN) { tr_item8(a.in[I_FD], FFD, DM, ws + WS_WDN, 0, r, scr, lane); continue; } r -= I_FDN;
        tr_item(a.in[I_PW] + (size_t)(r >> 5) * 65536, 256, 256, (bf16_t*)(ws + WS_WPOOL) + (size_t)(r >> 5) * 65536, 0, r & 31, scr, lane);
    }
    { const int x0 = G == 256 ? MOE_X0 : NMOE, nfree = G > N_ADA_BLK ? G - N_ADA_BLK : 0, pre = nfree > 0 ? (2 * 8 * nfree < x0 ? 2 * 8 * nfree : x0) : 0;
      if ((int)blockIdx.x >= N_ADA_BLK) moe_stream(a, scr, ((int)blockIdx.x - N_ADA_BLK) * 8 + wave, pre, nfree * 8, lane);
      moe_stream(a, scr, pre + (gw + NGW - (NITEMS % NGW)) % NGW, x0, NGW, lane); }
}
__device__ __forceinline__ void p0b_modreduce(const Args& a, int G) {
    const float* part = (const float*)(a.ws + WS_PART); float* mod = (float*)(a.ws + WS_MOD);
    for (int idx = blockIdx.x * 512 + TIDX_OF(a.wv); idx < 2 * 5 * 1536; idx += G * 512) {
        const int l = idx / 7680, r = idx - l * 7680, b = r / 1536, j4 = r - b * 1536;
        f32x4 s = *(const f32x4*)(a.in[I_BADA] + l * 6144 + j4 * 4);
        f32x4 pv[32];
#pragma unroll
        for (int kc = 0; kc < 32; ++kc) pv[kc] = *(const f32x4*)(part + (((size_t)(l * 32 + kc) * 5 + b) * 6144 + j4 * 4));
#pragma unroll
        for (int kc = 0; kc < 32; ++kc) s = s + pv[kc];
        *(f32x4*)(mod + (size_t)(l * 5 + b) * 6144 + j4 * 4) = s;
    }
}

__device__ __forceinline__ void mod_row(const float* xrow, const float* shift, const float* scale, bf16_t* orow, int lane) {
    const f32x4* xr = (const f32x4*)xrow + lane; f32x4 v[4]; float ss = 0.f;
#pragma unroll
    for (int j = 0; j < 4; ++j) { v[j] = xr[64 * j]; ss += (v[j][0] * v[j][0] + v[j][1] * v[j][1]) + (v[j][2] * v[j][2] + v[j][3] * v[j][3]); }
    const float rstd = rsqrtf(wave_sum(ss) * (1.0f / DM) + EPS);
#pragma unroll
    for (int j = 0; j < 4; ++j) { const f32x4 sh = ((const f32x4*)shift)[lane + 64 * j], sc = ((const f32x4*)scale)[lane + 64 * j];
        st_bf4(orow + (lane + 64 * j) * 4, v[j] * rstd * (sc + 1.0f) + sh); }
}
__device__ __forceinline__ f32x2 ld_bf2(const bf16_t* p) { const unsigned w = *(const unsigned*)p; return (f32x2){bf_lo(w), bf_hi(w)}; }
__device__ __forceinline__ f32x4 ld_bf4(const bf16_t* p) { const u32x2 w = *(const u32x2*)p; return (f32x4){bf_lo(w.x), bf_hi(w.x), bf_lo(w.y), bf_hi(w.y)}; }
template <int N, class XT> __device__ __forceinline__ void mod_rows(const XT* x, int nvalid, const float* m, bf16_t* o, int lane) {
    f32x4 v[N][4]; float ss[N];
#pragma unroll
    for (int i = 0; i < N; ++i)
#pragma unroll
        for (int j = 0; j < 4; ++j) { const size_t off = (size_t)(i < nvalid ? i : 0) * DM; if constexpr (sizeof(XT) == 4) v[i][j] = ((const f32x4*)((const float*)x + off))[lane + 64 * j]; else v[i][j] = ld_bf4((const bf16_t*)x + off + (lane + 64 * j) * 4); }
#pragma unroll
    for (int i = 0; i < N; ++i) { float t = 0.f;
#pragma unroll
        for (int j = 0; j < 4; ++j) t += (v[i][j][0] * v[i][j][0] + v[i][j][1] * v[i][j][1]) + (v[i][j][2] * v[i][j][2] + v[i][j][3] * v[i][j][3]);
        ss[i] = rsqrtf(wave_sum(t) * (1.0f / DM) + EPS); }
#pragma unroll
    for (int j = 0; j < 4; ++j) { const f32x4 sh = ((const f32x4*)m)[lane + 64 * j], sc = ((const f32x4*)(m + DM))[lane + 64 * j] + 1.0f;
#pragma unroll
        for (int i = 0; i < N; ++i) if (i < nvalid) st_bf4(o + (size_t)i * DM + (lane + 64 * j) * 4, v[i][j] * ss[i] * sc + sh); }
}
__device__ __forceinline__ void p1_modulate0(const Args& a, int G) {
    const int lane = lane_id(), gw = blockIdx.x * 8 + a.wv, NGW = G * 8;
    const float* mod = (const float*)(a.ws + WS_MOD);
    for (int r = gw * 4; r < MTOK; r += NGW * 4) mod_rows<4, float>(a.in[I_X] + (size_t)r * DM, 4, mod + (size_t)(r >> 12) * 6144, (bf16_t*)(a.ws + WS_H) + (size_t)r * DM, lane);
    for (int r = gw; r < MCTX; r += NGW) mod_rows<1, float>(a.in[I_CTX] + (size_t)r * DM, 1, mod + (size_t)4 * 6144, (bf16_t*)(a.ws + WS_HC) + (size_t)r * DM, lane);
}
__device__ __forceinline__ void p5_modulate1(const Args& a, int G) {
    const int lane = lane_id(), gw = blockIdx.x * 8 + a.wv, NGW = G * 8;
    const float* mod = (const float*)(a.ws + WS_MOD); const bf16_t* XR = (const bf16_t*)(a.ws + WS_XR);
    for (int r = gw * 4; r < MTOK; r += NGW * 4) mod_rows<4, bf16_t>(XR + (size_t)r * DM, 4, mod + (size_t)(r >> 12) * 6144 + 3 * DM, (bf16_t*)(a.ws + WS_H) + (size_t)r * DM, lane);
}

__device__ __forceinline__ float pmax32(float m) { auto rr = __builtin_amdgcn_permlane32_swap(__float_as_uint(m), __float_as_uint(m), false, false); return fmaxf(__uint_as_float(rr[0]), __uint_as_float(rr[1])); }
__device__ __forceinline__ float psum32(float m) { auto rr = __builtin_amdgcn_permlane32_swap(__float_as_uint(m), __float_as_uint(m), false, false); return __uint_as_float(rr[0]) + __uint_as_float(rr[1]); }
__device__ __forceinline__ bf16x8 pack8(const f32x16& p, int b) {
    u32x4 w; w.x = cvt_pk_bf16(p[b + 0], p[b + 1]); w.y = cvt_pk_bf16(p[b + 2], p[b + 3]); w.z = cvt_pk_bf16(p[b + 4], p[b + 5]); w.w = cvt_pk_bf16(p[b + 6], p[b + 7]);
    return __builtin_bit_cast(bf16x8, w);
}
constexpr float ATT_THR = 4.0f;
__device__ __forceinline__ void attn_tile(const LAS bf16_t* Kt, const LAS bf16_t* Vt, int vrs, int mode, const bf16x8 (&qf)[4], float& m_run, float& l_run, f32x16& O0, f32x16& O1, int qq0, int r32, int hi) {
    f32x16 p0 = {}, p1 = {};
#pragma unroll
    for (int d0 = 0; d0 < 4; ++d0) { const bf16x8 k0 = *(const LAS bf16x8*)(Kt + r32 * 72 + 16 * d0 + 8 * hi), k1 = *(const LAS bf16x8*)(Kt + (32 + r32) * 72 + 16 * d0 + 8 * hi);
        p0 = __builtin_amdgcn_mfma_f32_32x32x16_bf16(k0, qf[d0], p0, 0, 0, 0); p1 = __builtin_amdgcn_mfma_f32_32x32x16_bf16(k1, qf[d0], p1, 0, 0, 0); }
    if (mode) { const int qq = qq0 + r32;
#pragma unroll
        for (int r = 0; r < 16; ++r) { const int kk = (r & 3) + 8 * (r >> 2) + 4 * hi;
            const bool k0 = mode == 1 ? (kk >= qq) : (kk <= qq), k1 = mode == 1 ? (kk + 32 >= qq) : (kk + 32 <= qq);
            if (!k0) p0[r] = -1e30f; if (!k1) p1[r] = -1e30f; } }
    float mxa = fmaxf(p0[0], p1[0]), mxb = fmaxf(p0[1], p1[1]), mxc = fmaxf(p0[2], p1[2]), mxd = fmaxf(p0[3], p1[3]);
#pragma unroll
    for (int r = 4; r < 16; r += 4) { mxa = fmaxf(mxa, fmaxf(p0[r], p1[r])); mxb = fmaxf(mxb, fmaxf(p0[r + 1], p1[r + 1])); mxc = fmaxf(mxc, fmaxf(p0[r + 2], p1[r + 2])); mxd = fmaxf(mxd, fmaxf(p0[r + 3], p1[r + 3])); }
    float mx = pmax32(fmaxf(fmaxf(mxa, mxb), fmaxf(mxc, mxd)));
    if (__any(mx > m_run + ATT_THR)) {
        const float mn = fmaxf(m_run, mx), alpha = fast_exp2(m_run - mn); m_run = mn; l_run *= alpha;
#pragma unroll
        for (int r = 0; r < 16; ++r) { O0[r] *= alpha; O1[r] *= alpha; } }
    p0 = p0 - m_run; p1 = p1 - m_run;
#pragma unroll
    for (int r = 0; r < 16; ++r) { p0[r] = fast_exp2(p0[r]); p1[r] = fast_exp2(p1[r]); }
    { const f32x16 ps = p0 + p1;
      const f32x4 q4 = (f32x4){ps[0], ps[1], ps[2], ps[3]} + (f32x4){ps[4], ps[5], ps[6], ps[7]} + ((f32x4){ps[8], ps[9], ps[10], ps[11]} + (f32x4){ps[12], ps[13], ps[14], ps[15]});
      l_run += (q4[0] + q4[1]) + (q4[2] + q4[3]); }
    bf16x8 pb[4]; pb[0] = pack8(p0, 0); pb[1] = pack8(p0, 8); pb[2] = pack8(p1, 0); pb[3] = pack8(p1, 8);
#pragma unroll
    for (int kg = 0; kg < 4; ++kg) { const bf16x8 v0 = *(const LAS bf16x8*)(Vt + r32 * vrs + 16 * kg + 8 * hi), v1 = *(const LAS bf16x8*)(Vt + (32 + r32) * vrs + 16 * kg + 8 * hi);
        O0 = __builtin_amdgcn_mfma_f32_32x32x16_bf16(v0, pb[kg], O0, 0, 0, 0); O1 = __builtin_amdgcn_mfma_f32_32x32x16_bf16(v1, pb[kg], O1, 0, 0, 0); }
}
__device__ __forceinline__ int permkey(int k) { return (k & ~12) | ((k & 4) << 1) | ((k & 8) >> 1); }
constexpr int ACH_VRS = 136, ACH_KB = 128 * 72 * 2, ACH_B = ACH_KB + 64 * ACH_VRS * 2;
__device__ __forceinline__ void attn_unit(LAS unsigned char* lds, const bf16_t* PROJ, const bf16_t* KVC, const float* sink, bf16_t* MIX, int b, int n, int h, int wv) {
    const int tid = TIDX_OF(wv), lane = tid & 63, wid = wv, r32 = lane & 31, hi = lane >> 5;
    const int g = wid >> 1, half = wid & 1, hq = h * 4 + g;
    const int rowq = b * SEQ + n * 128 + half * 64;
    bf16x8 qf[2][4];
#pragma unroll
    for (int qb = 0; qb < 2; ++qb)
#pragma unroll
        for (int d0 = 0; d0 < 4; ++d0) qf[qb][d0] = *(const bf16x8*)(PROJ + (size_t)(rowq + qb * 32 + r32) * INW + hq * 64 + d0 * 16 + hi * 8);
    float m_run[2], l_run[2]; f32x16 O[2][2];
    const float sl2 = sink[hq] * LOG2E;
#pragma unroll
    for (int qb = 0; qb < 2; ++qb) { m_run[qb] = sl2; l_run[qb] = hi == 0 ? 1.0f : 0.0f; O[qb][0] = f32x16{}; O[qb][1] = f32x16{}; }
    const int krow0 = tid >> 3, kch = tid & 7, vkey = tid & 127, vch = tid >> 7, vpk = permkey(vkey);
    u32x4 kreg[2], vreg[2];
    const int c0 = n == 0 ? 1 : 0;
#define ATT_SRC(c, kp, vp, ld) const bf16_t* kp; int ld; if ((c) < 3) { kp = PROJ + ((size_t)b * SEQ + (size_t)(n - 1 + (c)) * 128) * INW + 512 + h * 64; ld = INW; } else { kp = KVC + ((size_t)b * CTXL + ((c) - 3) * 128) * 256 + h * 64; ld = 256; } const bf16_t* vp = kp + 128;
#define ATT_LOAD(c) do { ATT_SRC(c, kp_, vp_, ld_) \
        _Pragma("unroll") for (int i = 0; i < 2; ++i) { kreg[i] = *(const u32x4*)(kp_ + (size_t)(krow0 + 64 * i) * ld_ + kch * 8); vreg[i] = *(const u32x4*)(vp_ + (size_t)vkey * ld_ + (vch + 4 * i) * 8); } } while (0)
#define ATT_WRITE(buf) do { LAS bf16_t* KS_ = (LAS bf16_t*)(lds + (buf) * ACH_B); LAS bf16_t* VT_ = (LAS bf16_t*)(lds + (buf) * ACH_B + ACH_KB); \
        _Pragma("unroll") for (int i = 0; i < 2; ++i) { *(LAS u32x4*)(KS_ + (krow0 + 64 * i) * 72 + kch * 8) = kreg[i]; LAS bf16_t* vq = VT_ + ((vch + 4 * i) * 8) * ACH_VRS + vpk; const u32x4 v = vreg[i]; \
            vq[0 * ACH_VRS] = (bf16_t)(v.x & 0xffff); vq[1 * ACH_VRS] = (bf16_t)(v.x >> 16); vq[2 * ACH_VRS] = (bf16_t)(v.y & 0xffff); vq[3 * ACH_VRS] = (bf16_t)(v.y >> 16); \
            vq[4 * ACH_VRS] = (bf16_t)(v.z & 0xffff); vq[5 * ACH_VRS] = (bf16_t)(v.z >> 16); vq[6 * ACH_VRS] = (bf16_t)(v.w & 0xffff); vq[7 * ACH_VRS] = (bf16_t)(v.w >> 16); } } while (0)
    ATT_LOAD(c0); ATT_WRITE(0);
    __syncthreads();
    int buf = 0;
#pragma unroll 1
    for (int c = c0; c < 5; ++c) {
        if (c == 2 && n == 31) continue;
        int cn = c + 1; if (cn == 2 && n == 31) cn = 3;
        if (cn < 5) ATT_LOAD(cn);
        const LAS bf16_t* KS = (const LAS bf16_t*)(lds + buf * ACH_B); const LAS bf16_t* VT = (const LAS bf16_t*)(lds + buf * ACH_B + ACH_KB);
#pragma unroll 1
        for (int t = 0; t < 2; ++t) {
            int mode = 0;
            if (c < 3) { const int rel = 2 * (c - 1) + t - half; if (rel < -2 || rel > 2) continue; mode = rel == -2 ? 1 : (rel == 2 ? 2 : 0); }
#pragma unroll
            for (int qb = 0; qb < 2; ++qb) { attn_tile(KS + 64 * t * 72, VT + 64 * t, ACH_VRS, mode, qf[qb], m_run[qb], l_run[qb], O[qb][0], O[qb][1], qb * 32, r32, hi); __builtin_amdgcn_sched_barrier(0); }
        }
        if (cn < 5) ATT_WRITE(buf ^ 1);
        __syncthreads();
        buf ^= 1;
    }
#undef ATT_SRC
#undef ATT_LOAD
#undef ATT_WRITE
#pragma unroll
    for (int qb = 0; qb < 2; ++qb) { const float inv = 1.0f / psum32(l_run[qb]); bf16_t* op = MIX + (size_t)(rowq + qb * 32 + r32) * DM + hq * 64 + 4 * hi;
#pragma unroll
        for (int db = 0; db < 2; ++db)
#pragma unroll
            for (int rq = 0; rq < 4; ++rq) st_bf4(op + 32 * db + 8 * rq, (f32x4){O[qb][db][4 * rq] * inv, O[qb][db][4 * rq + 1] * inv, O[qb][db][4 * rq + 2] * inv, O[qb][db][4 * rq + 3] * inv}); }
}
__device__ __forceinline__ void gate_unit(LAS unsigned char* lds, const bf16_t* PROJ, const float* ssq, const float* gm_w_s, const float* gm_gain, const float* gm_b_s, bf16_t* MIX, int g, int b, int cq, int wv) {
    const int tid = TIDX_OF(wv), lane = tid & 63, wid = wv, r32 = lane & 31, hi = lane >> 5;
    LAS bf16_t* WS = (LAS bf16_t*)lds;
    const int s_ = tid & 127, ch = tid >> 7;
    const f32x4 ga0 = *(const f32x4*)(gm_gain + g * 64 + ch * 8), ga1 = *(const f32x4*)(gm_gain + g * 64 + ch * 8 + 4), gb0 = *(const f32x4*)(gm_gain + g * 64 + ch * 8 + 32), gb1 = *(const f32x4*)(gm_gain + g * 64 + ch * 8 + 36);
    u32x4 vreg[2]; f32x4 sq[2];
#define GT_LOAD(ck) do { const size_t row_ = (size_t)b * SEQ + (size_t)(ck) * 128 + s_; \
        vreg[0] = *(const u32x4*)(PROJ + row_ * INW + 1280 + g * 64 + ch * 8); vreg[1] = *(const u32x4*)(PROJ + row_ * INW + 1280 + g * 64 + (ch + 4) * 8); \
        sq[0] = *(const f32x4*)(ssq + row_ * 8); sq[1] = *(const f32x4*)(ssq + row_ * 8 + 4); } while (0)
#define GT_WRITE(buf) do { LAS bf16_t* VnT_ = (LAS bf16_t*)(lds + 34816 + (buf) * 17408); \
        const float rstd_ = rsqrtf((((sq[0][0] + sq[0][1]) + (sq[0][2] + sq[0][3])) + ((sq[1][0] + sq[1][1]) + (sq[1][2] + sq[1][3]))) * (1.0f / 512.0f) + EPS); \
        _Pragma("unroll") for (int i = 0; i < 2; ++i) { const u32x4 v = vreg[i]; const f32x4 g0 = (i ? gb0 : ga0) * rstd_, g1 = (i ? gb1 : ga1) * rstd_; \
            const unsigned w0 = cvt_pk_bf16(bf_lo(v.x) * g0[0], bf_hi(v.x) * g0[1]), w1 = cvt_pk_bf16(bf_lo(v.y) * g0[2], bf_hi(v.y) * g0[3]), w2 = cvt_pk_bf16(bf_lo(v.z) * g1[0], bf_hi(v.z) * g1[1]), w3 = cvt_pk_bf16(bf_lo(v.w) * g1[2], bf_hi(v.w) * g1[3]); \
            LAS bf16_t* vp = VnT_ + ((ch + 4 * i) * 8) * 136 + s_; \
            vp[0 * 136] = (bf16_t)(w0 & 0xffff); vp[1 * 136] = (bf16_t)(w0 >> 16); vp[2 * 136] = (bf16_t)(w1 & 0xffff); vp[3 * 136] = (bf16_t)(w1 >> 16); \
            vp[4 * 136] = (bf16_t)(w2 & 0xffff); vp[5 * 136] = (bf16_t)(w2 >> 16); vp[6 * 136] = (bf16_t)(w3 & 0xffff); vp[7 * 136] = (bf16_t)(w3 >> 16); } } while (0)
    GT_LOAD(4 * cq);
#pragma unroll
    for (int it = 0; it < 4; ++it) { const int id = tid + 512 * it, t = id >> 4, c8 = id & 15; const float* wp = gm_w_s + ((size_t)g * 128 + t) * 128 + c8 * 8;
        const f32x4 w0 = *(const f32x4*)wp, w1 = *(const f32x4*)(wp + 4); u32x4 o; o.x = cvt_pk_bf16(w0[0], w0[1]); o.y = cvt_pk_bf16(w0[2], w0[3]); o.z = cvt_pk_bf16(w1[0], w1[1]); o.w = cvt_pk_bf16(w1[2], w1[3]);
        *(LAS u32x4*)(WS + t * 136 + c8 * 8) = o; }
    GT_WRITE(0);
    __syncthreads();
    const int wt = wid >> 1, wd = wid & 1, t = 32 * wt + r32; const float bias = gm_b_s[g * 128 + t];
#pragma unroll 1
    for (int k = 0; k < 4; ++k) { const int ck = 4 * cq + k, buf = k & 1; const size_t row = (size_t)b * SEQ + (size_t)ck * 128 + t;
        if (k < 3) GT_LOAD(ck + 1);
        u32x2 uu[4];
#pragma unroll
        for (int rq = 0; rq < 4; ++rq) uu[rq] = *(const u32x2*)(PROJ + row * INW + 768 + g * 64 + 32 * wd + 8 * rq + 4 * hi);
        const LAS bf16_t* VnT = (const LAS bf16_t*)(lds + 34816 + buf * 17408); f32x16 acc = {};
#pragma unroll
        for (int ks = 0; ks < 8; ++ks) { const bf16x8 af = *(const LAS bf16x8*)(VnT + (32 * wd + r32) * 136 + 16 * ks + 8 * hi), bfr = *(const LAS bf16x8*)(WS + (32 * wt + r32) * 136 + 16 * ks + 8 * hi);
            acc = __builtin_amdgcn_mfma_f32_32x32x16_bf16(af, bfr, acc, 0, 0, 0); }
#pragma unroll
        for (int rq = 0; rq < 4; ++rq) { const int d0 = 32 * wd + 8 * rq + 4 * hi;
            st_bf4(MIX + row * DM + 512 + g * 64 + d0, (f32x4){bf_lo(uu[rq].x) * (acc[4 * rq] + bias), bf_hi(uu[rq].x) * (acc[4 * rq + 1] + bias), bf_lo(uu[rq].y) * (acc[4 * rq + 2] + bias), bf_hi(uu[rq].y) * (acc[4 * rq + 3] + bias)}); }
        if (k < 3) GT_WRITE(buf ^ 1);
        __syncthreads();
    }
#undef GT_LOAD
#undef GT_WRITE
}
__device__ __forceinline__ void p3_mixers(const Args& a, LAS unsigned char* lds, int G) {
    const bf16_t* PROJ = (const bf16_t*)(a.ws + WS_PROJ); const bf16_t* KVC = (const bf16_t*)(a.ws + WS_KVC); bf16_t* MIX = (bf16_t*)(a.ws + WS_MIX);
    for (int u = blockIdx.x; u < 256; u += G) attn_unit(lds, PROJ, KVC, a.in[I_SINK], MIX, u >> 6, (u >> 1) & 31, u & 1, a.wv);
    for (int u = blockIdx.x; u < 256; u += G) gate_unit(lds, PROJ, (const float*)(a.ws + WS_SSQ), a.in[I_GMWS], a.in[I_GMGAIN], a.in[I_GMBS], MIX, u & 7, u >> 6, (u >> 3) & 7, a.wv);
}

template <int W> __device__ __forceinline__ void pool_half(const bf16_t* xc, bf16_t* dp, const LAS float* rsp, int lo, int tb, f32x2 sc) {
    constexpr int BEF = W / 2, AFT = W - 1 - BEF, NR = 32 + W - 1;
    f32x2 xv[NR];
#pragma unroll
    for (int k = 0; k < NR; ++k) { const int j = tb - BEF + k; xv[k] = (j >= 0 && j <= SEQ - 1) ? ld_bf2(xc + (size_t)j * DM) : (f32x2){0.f, 0.f}; }
#pragma unroll
    for (int k = 0; k < NR; ++k) { const int j = tb - BEF + k; xv[k] = xv[k] * ((j >= 0 && j <= SEQ - 1) ? rsp[j - lo] : 0.f); }
    f32x2 sum = xv[0];
#pragma unroll
    for (int k = 1; k < W; ++k) sum = sum + xv[k];
#pragma unroll
    for (int i = 0; i < 32; ++i) { const int t = tb + i, l2 = t - BEF < 0 ? 0 : t - BEF, h2 = t + AFT > SEQ - 1 ? SEQ - 1 : t + AFT;
        const f32x2 d = (sum * (1.0f / (float)(h2 - l2 + 1)) - xv[i + BEF]) * sc;
        *(unsigned*)(dp + (size_t)t * DM) = cvt_pk_bf16(d[0], d[1]);
        if (i < 31) sum = sum + xv[i + W] - xv[i]; }
}
__device__ __forceinline__ void p8_pooldiff(const Args& a, LAS unsigned char* lds, int G) {
    const int tid = TIDX_OF(a.wv), lane = tid & 63, wid = a.wv;
    LAS float* rsp = (LAS float*)lds;
    const float* mod1 = (const float*)(a.ws + WS_MOD) + (size_t)5 * 6144; bf16_t* DIFF = (bf16_t*)(a.ws + WS_DIFF);
    for (int tile = blockIdx.x; tile < 256; tile += G) {
        const int r0 = tile * 64, b = r0 >> 12, t0 = r0 & (SEQ - 1), lo = t0 - 8 < 0 ? 0 : t0 - 8, hi = t0 + 71 > SEQ - 1 ? SEQ - 1 : t0 + 71, nrows = hi - lo + 1;
        const bf16_t* xb = (const bf16_t*)(a.ws + WS_XR) + (size_t)b * SEQ * DM;
        if (tid < nrows) { const f32x4* sp = (const f32x4*)((const float*)(a.ws + WS_SSQ2) + (size_t)(b * SEQ + lo + tid) * 64);
            f32x4 sv[16];
#pragma unroll
            for (int k = 0; k < 16; ++k) sv[k] = sp[k];
            f32x4 t4 = sv[0];
#pragma unroll
            for (int k = 1; k < 16; ++k) t4 = t4 + sv[k];
            rsp[tid] = rsqrtf(((t4[0] + t4[1]) + (t4[2] + t4[3])) * (1.0f / DM) + EPS); }
        __syncthreads();
        const int c = 2 * tid, gi = c >> 8;
        const f32x2 sc = *(const f32x2*)(mod1 + (size_t)b * 6144 + DM + c) + 1.0f;
        bf16_t* dp = DIFF + (size_t)(b * SEQ) * DM + c;
#pragma unroll 1
        for (int hf = 0; hf < 2; ++hf) { const int tb = t0 + 32 * hf;
            if (gi == 0) pool_half<2>(xb + c, dp, rsp, lo, tb, sc); else if (gi == 1) pool_half<4>(xb + c, dp, rsp, lo, tb, sc); else if (gi == 2) pool_half<8>(xb + c, dp, rsp, lo, tb, sc); else pool_half<16>(xb + c, dp, rsp, lo, tb, sc); }
        __syncthreads();
    }
}

__device__ __forceinline__ void p10_router(const Args& a, LAS unsigned char* lds, int G) {
    const int tid = TIDX_OF(a.wv), lane = tid & 63, wid = a.wv;
    LAS float* RW = (LAS float*)lds;
    LAS int* esel = (LAS int*)(lds + 32768);
    { float rwv[16];
#pragma unroll
      for (int k = 0; k < 16; ++k) rwv[k] = a.in[I_RW][tid + 512 * k];
#pragma unroll
      for (int k = 0; k < 16; ++k) { const int idx = tid + 512 * k; RW[(idx & 7) * DM + (idx >> 3)] = rwv[k]; } }
    __syncthreads();
    const float* mod1 = (const float*)(a.ws + WS_MOD) + (size_t)5 * 6144;
    int* rte = (int*)(a.ws + WS_RTE); float* rtw = (float*)(a.ws + WS_RTW); int* cntb = (int*)(a.ws + WS_CNTB);
    unsigned char* H8 = a.ws + WS_H;
    for (int tile = blockIdx.x; tile < 256; tile += G) {
        const bf16_t* XR = (const bf16_t*)(a.ws + WS_XR);
#pragma unroll 1
        for (int st = 0; st < 2; ++st) {
            const int lr0 = wid * 8 + st * 4, row0 = tile * 64 + lr0, b = row0 >> 12;
            f32x4 v[4][4]; float rstd[4];
#pragma unroll
            for (int i = 0; i < 4; ++i)
#pragma unroll
                for (int j = 0; j < 4; ++j) v[i][j] = ld_bf4(XR + (size_t)(row0 + i) * DM + (lane + 64 * j) * 4);
#pragma unroll
            for (int i = 0; i < 4; ++i) { float ss = 0.f;
#pragma unroll
                for (int j = 0; j < 4; ++j) ss += (v[i][j][0] * v[i][j][0] + v[i][j][1] * v[i][j][1]) + (v[i][j][2] * v[i][j][2] + v[i][j][3] * v[i][j][3]);
                rstd[i] = rsqrtf(wave_sum(ss) * (1.0f / DM) + EPS); }
            const float* mb = mod1 + (size_t)b * 6144 + 3 * DM;
            float lg[4][8];
#pragma unroll
            for (int i = 0; i < 4; ++i)
#pragma unroll
                for (int e = 0; e < 8; ++e) lg[i][e] = 0.f;
#pragma unroll
            for (int j = 0; j < 4; ++j) { const f32x4 sh = ((const f32x4*)mb)[lane + 64 * j], sc = ((const f32x4*)(mb + DM))[lane + 64 * j] + 1.0f;
#pragma unroll
                for (int i = 0; i < 4; ++i) { v[i][j] = v[i][j] * rstd[i] * sc + sh;
                    const f32x4 h8 = v[i][j] * HSC; *(unsigned*)(H8 + (size_t)(row0 + i) * DM + (lane + 64 * j) * 4) = pk_fp8x4(h8[0], h8[1], h8[2], h8[3]); }
#pragma unroll
                for (int e = 0; e < 8; ++e) { const f32x4 w = *(const LAS f32x4*)(RW + e * DM + (lane + 64 * j) * 4);
#pragma unroll
                    for (int i = 0; i < 4; ++i) lg[i][e] += (v[i][j][0] * w[0] + v[i][j][1] * w[1]) + (v[i][j][2] * w[2] + v[i][j][3] * w[3]); } }
#pragma unroll
            for (int i = 0; i < 4; ++i) {
#pragma unroll
                for (int e = 0; e < 8; ++e) lg[i][e] = wave_sum(lg[i][e]);
                float v0 = lg[i][0]; int i0 = 0;
#pragma unroll
                for (int e = 1; e < 8; ++e) if (lg[i][e] > v0) { v0 = lg[i][e]; i0 = e; }
                float v1 = -3.0e38f; int i1 = 0;
#pragma unroll
                for (int e = 0; e < 8; ++e) if (e != i0 && lg[i][e] > v1) { v1 = lg[i][e]; i1 = e; }
                const float ex = __expf(v1 - v0), w0 = 1.0f / (1.0f + ex), w1 = ex * w0; const int row = row0 + i, lr = lr0 + i;
                if (lane == 0) { rte[row * 2] = i0; rte[row * 2 + 1] = i1; rtw[row * 2] = w0; rtw[row * 2 + 1] = w1; esel[lr * 2] = i0; esel[lr * 2 + 1] = i1; } }
        }
        __syncthreads();
        if (tid < 8) { const int e = tid; int cnt = 0;
            for (int p = 0; p < 128; ++p) cnt += (esel[p] == e) ? 1 : 0;
            cntb[tile * 8 + e] = cnt; }
        __syncthreads();
    }
}
__device__ __forceinline__ void p10b_sort(const Args& a, LAS unsigned char* lds, int G) {
    const int tid = TIDX_OF(a.wv), lane = tid & 63, wid = a.wv;
    LAS int* cs = (LAS int*)lds;
    LAS int* basee = (LAS int*)(lds + 8192);
    LAS int* tote = (LAS int*)(lds + 8192 + 32);
    LAS int* w0cnt = (LAS int*)(lds + 8192 + 64);
    LAS int* dest = (LAS int*)(lds + 8192 + 128);
    const int* cntb = (const int*)(a.ws + WS_CNTB); const int* rte = (const int*)(a.ws + WS_RTE); int* pos = (int*)(a.ws + WS_POS); int* totg = (int*)(a.ws + WS_TOT);
    const unsigned char* H8 = a.ws + WS_H; unsigned char* XS = a.ws + WS_XS;
    for (int tile = blockIdx.x; tile < 256; tile += G) {
        for (int i = tid; i < 2048; i += 512) cs[i] = cntb[i];
        __syncthreads();
        { const int e = wid; int tsum = 0, bsum = 0;
#pragma unroll
          for (int k = 0; k < 4; ++k) { const int t = lane + 64 * k, v = cs[t * 8 + e]; tsum += v; bsum += t < tile ? v : 0; }
#pragma unroll
          for (int o = 1; o < 64; o <<= 1) { tsum += __shfl_xor(tsum, o); bsum += __shfl_xor(bsum, o); }
          if (lane == 0) { basee[e] = bsum; tote[e] = tsum; if (tile == 0) totg[e] = tsum; } }
        int mye = 0, rank = 0;
        if (wid < 2) { mye = rte[tile * 128 + tid];
#pragma unroll
            for (int e = 0; e < 8; ++e) { const unsigned long long bm = __ballot(mye == e); if (mye == e) rank = __popcll(bm & ((1ull << lane) - 1ull)); if (wid == 0 && lane == 0) w0cnt[e] = __popcll(bm); } }
        __syncthreads();
        if (wid < 2) { int rs = 0;
#pragma unroll
            for (int e = 0; e < 8; ++e) { const int te = tote[e]; if (e < mye) rs += (te + 255) >> 8; }
            const int d = rs * 256 + basee[mye] + rank + (wid == 1 ? w0cnt[mye] : 0);
            dest[tid] = d; pos[tile * 128 + tid] = d; }
        __syncthreads();
        { u32x4 cv[16];
#pragma unroll
          for (int pp = 0; pp < 16; ++pp) cv[pp] = *(const u32x4*)(H8 + (size_t)(tile * 64 + ((wid * 16 + pp) >> 1)) * DM + lane * 16);
#pragma unroll
          for (int pp = 0; pp < 16; ++pp) *(u32x4*)(XS + (size_t)dest[wid * 16 + pp] * DM + lane * 16) = cv[pp]; }
        __syncthreads();
    }
    { int nt = 0;
#pragma unroll
      for (int e = 0; e < 8; ++e) nt += (tote[e] + 255) >> 8;
      const int gp = moe_gu_groups(nt, G), hq = moe_h3_quota(G - gp), wave = a.wv;
      __syncthreads();
      moe_stream(a, (LAS float*)(lds + wave * 16896), MOE_X2 + hq + blockIdx.x * 8 + wave, NMOE, G * 8, lane); }
}

__device__ __forceinline__ u32x2 ysplit(const bf16_t* YS, int row, int col) {
    f32x4 acc = {0.f, 0.f, 0.f, 0.f};
#pragma unroll
    for (int kc = 0; kc < 7; ++kc) acc = acc + ld_bf4(YS + ((size_t)kc * 2048 + row) * DM + col);
    u32x2 w; w.x = cvt_pk_bf16(acc[0], acc[1]); w.y = cvt_pk_bf16(acc[2], acc[3]); return w;
}
__device__ __forceinline__ void p13_final(const Args& a, int G, bool use_y) {
    const int lane = lane_id(), wave = a.wv, gw = blockIdx.x * 8 + wave, NGW = G * 8;
    const float* mod1 = (const float*)(a.ws + WS_MOD) + (size_t)5 * 6144; const bf16_t* Y = (const bf16_t*)(a.ws + WS_Y); const int* pos = (const int*)(a.ws + WS_POS); const float* rtw = (const float*)(a.ws + WS_RTW);
    MoeTiles T; T.init((const int*)(a.ws + WS_TOT)); const int nsplit = moe_nsplit(T.p8, G), split0 = (T.p8 - nsplit) * 256; const bf16_t* YS = (const bf16_t*)(a.ws + WS_YS);
#define LDY(q, j) ((q) < split0 ? *(const u32x2*)(Y + (size_t)(q) * DM + (lane + 64 * (j)) * 4) : ysplit(YS, (q) - split0, (lane + 64 * (j)) * 4))
    for (int r0 = gw; r0 < MTOK; r0 += 2 * NGW) {
        const bool two = r0 + NGW < MTOK; const int rA = r0, rB = two ? r0 + NGW : r0;
        const int qa0 = pos[2 * rA], qa1 = pos[2 * rA + 1], qb0 = pos[2 * rB], qb1 = pos[2 * rB + 1];
        const float wa0 = rtw[2 * rA], wa1 = rtw[2 * rA + 1], wb0 = rtw[2 * rB], wb1 = rtw[2 * rB + 1];
        f32x4* xa = (f32x4*)(a.out + (size_t)rA * DM) + lane; f32x4* xb = (f32x4*)(a.out + (size_t)rB * DM) + lane;
        const bf16_t* xia = (const bf16_t*)(a.ws + WS_XR) + (size_t)rA * DM; const bf16_t* xib = (const bf16_t*)(a.ws + WS_XR) + (size_t)rB * DM;
        const float* ga = mod1 + (size_t)(rA >> 12) * 6144 + 5 * DM; const float* gb = mod1 + (size_t)(rB >> 12) * 6144 + 5 * DM;
        f32x4 va[4], vb[4]; u32x2 ya0[4], ya1[4], yb0[4], yb1[4];
#pragma unroll
        for (int j = 0; j < 4; ++j) { va[j] = ld_bf4(xia + (lane + 64 * j) * 4); vb[j] = ld_bf4(xib + (lane + 64 * j) * 4);
            ya0[j] = LDY(qa0, j); ya1[j] = LDY(qa1, j); yb0[j] = LDY(qb0, j); yb1[j] = LDY(qb1, j); }
        float sa = 0.f, sb = 0.f;
#pragma unroll
        for (int j = 0; j < 4; ++j) {
            if (use_y) { const f32x4 ysa = (f32x4){wa0 * bf_lo(ya0[j].x) + wa1 * bf_lo(ya1[j].x), wa0 * bf_hi(ya0[j].x) + wa1 * bf_hi(ya1[j].x), wa0 * bf_lo(ya0[j].y) + wa1 * bf_lo(ya1[j].y), wa0 * bf_hi(ya0[j].y) + wa1 * bf_hi(ya1[j].y)};
                const f32x4 ysb = (f32x4){wb0 * bf_lo(yb0[j].x) + wb1 * bf_lo(yb1[j].x), wb0 * bf_hi(yb0[j].x) + wb1 * bf_hi(yb1[j].x), wb0 * bf_lo(yb0[j].y) + wb1 * bf_lo(yb1[j].y), wb0 * bf_hi(yb0[j].y) + wb1 * bf_hi(yb1[j].y)};
                va[j] = va[j] + ((const f32x4*)ga)[lane + 64 * j] * ysa; vb[j] = vb[j] + ((const f32x4*)gb)[lane + 64 * j] * ysb; }
            sa += (va[j][0] * va[j][0] + va[j][1] * va[j][1]) + (va[j][2] * va[j][2] + va[j][3] * va[j][3]); sb += (vb[j][0] * vb[j][0] + vb[j][1] * vb[j][1]) + (vb[j][2] * vb[j][2] + vb[j][3] * vb[j][3]); }
        sa = wave_sum(sa); sb = wave_sum(sb);
        const float ra = rsqrtf(sa * (1.0f / DM) + EPS), rb = rsqrtf(sb * (1.0f / DM) + EPS);
#pragma unroll
        for (int j = 0; j < 4; ++j) { const f32x4 fg = ((const f32x4*)a.in[I_FGAIN])[lane + 64 * j]; xa[64 * j] = va[j] * ra * fg; if (two) xb[64 * j] = vb[j] * rb * fg; }
    }
}

constexpr int NPHASE = 16;
constexpr int ARGTAB_OFF = LDSCTL_OFF + 256;
__device__ __forceinline__ unsigned long long ld_u64_uniform(LAS unsigned char* lds, int k) {
    const u32x2 v = *(const LAS u32x2*)(lds + ARGTAB_OFF + 8 * k);
    return ((unsigned long long)(unsigned)__builtin_amdgcn_readfirstlane((int)v.y) << 32) | (unsigned)__builtin_amdgcn_readfirstlane((int)v.x);
}
__device__ __forceinline__ void load_args(Args& a, LAS unsigned char* lds) {
#pragma unroll
    for (int k = 0; k < 22; ++k) a.in[k] = (const float*)(GAS const float*)ld_u64_uniform(lds, k);
    a.out = (float*)(GAS float*)ld_u64_uniform(lds, 22); a.ws = (unsigned char*)(GAS unsigned char*)ld_u64_uniform(lds, 23);
}
__global__ void __launch_bounds__(512, 2) dit_fwd(Args args) {
    extern __shared__ __attribute__((aligned(16))) unsigned char lds_raw[];
    LAS unsigned char* lds = (LAS unsigned char*)lds_raw;
    const int tid = threadIdx.x, G = gridDim.x, wv = __builtin_amdgcn_readfirstlane(tid >> 6);
    for (int u = tid; u < (LDS_BYTES - LDSCTL_OFF) / 4; u += 512) ((LAS unsigned*)(lds + LDSCTL_OFF))[u] = 0u;
    __syncthreads();
    if (tid == 0) { LAS unsigned long long* tab = (LAS unsigned long long*)(lds + ARGTAB_OFF);
#pragma unroll
        for (int k = 0; k < 22; ++k) tab[k] = (unsigned long long)args.in[k];
        tab[22] = (unsigned long long)args.out; tab[23] = (unsigned long long)args.ws; }
    __syncthreads();
#if MK_ONE_LAUNCH
    (void)xcd_barrier_post((unsigned*)(args.ws + WS_CTL) + CW_BAR, (volatile LAS unsigned*)(lds + LDSCTL_OFF + 64), wv);
#define GRID_BAR() do { XcdBarrier bar_; bar_.bar = (unsigned*)(GAS unsigned*)(ld_u64_uniform(lds, 23) + WS_CTL) + CW_BAR; bar_.x = xb_xcc_id(); bar_.st = (volatile LAS unsigned*)(lds + LDSCTL_OFF + 64); bar_.wv = wv; xcd_barrier(bar_); } while (0)
#else
#define GRID_BAR() do {} while (0)
#endif
    const int lo = args.ph_lo, hi = args.ph_hi;
#ifdef PH_ONLY
#define IN(k) ((k) == PH_ONLY && lo <= (k) && (k) < hi)
#else
#define IN(k) (lo <= (k) && (k) < hi)
#endif
#define SEAM(k) do { if (IN(k) && IN((k) == 0 ? 2 : (k) + 1)) GRID_BAR(); } while (0)
#define PH_BEGIN Args a; load_args(a, lds); a.wv = wv; unsigned char* ws = a.ws; float* mod = (float*)(ws + WS_MOD); (void)mod;

    if (IN(0)) { PH_BEGIN p0_prologue(a, lds, G); } SEAM(0);
    if (IN(2)) { PH_BEGIN p1_modulate0(a, G); } SEAM(2);
    if (IN(3)) { PH_BEGIN const int gp = G == 256 ? GP_PROJ : G; if ((int)blockIdx.x >= gp) { moe_convert_range(a, lds, MOE_X0, MOE_X1, (int)blockIdx.x - gp, G - gp); } else { JobProj J; J.KB = DM * 2; J.ldab = DM * 2; J.G = gp; J.c = blockIdx.x; J.H = (const bf16_t*)(ws + WS_H); J.WT = (const bf16_t*)(ws + WS_WIN); J.PROJ = (bf16_t*)(ws + WS_PROJ); J.KVC = (bf16_t*)(ws + WS_KVC); J.rope = (const float*)(ws + WS_ROPE); J.ssq = (float*)(ws + WS_SSQ);
        pg8::gemm_phase<JobProj, true>(lds, J, a.wv); } } SEAM(3);
    if (IN(4)) { PH_BEGIN p3_mixers(a, lds, G); } SEAM(4);
    if (IN(5)) { PH_BEGIN JobRes<false, true> J; J.KB = DM * 2; J.ldab = DM * 2; J.ascale = 1.0f; J.G = G; J.c = blockIdx.x; J.pool = 0; J.A = ws + WS_MIX; J.Bt = ws + WS_WOUT; J.xin = a.in[I_X]; J.xout = (bf16_t*)(ws + WS_XR); J.gate = mod + 2 * DM; J.cscale = nullptr; J.ssq2 = nullptr;
        pg8::gemm_phase<JobRes<false, true>, true>(lds, J, a.wv); } SEAM(5);
    if (IN(6)) { PH_BEGIN p5_modulate1(a, G); } SEAM(6);
    if (IN(7)) { PH_BEGIN const int gp = G == 256 ? GP_GU : G; if ((int)blockIdx.x >= gp) { moe_convert_range(a, lds, MOE_X1, MOE_X2, (int)blockIdx.x - gp, G - gp); } else { JobGU J; J.KB = DM * 2; J.ldab = DM * 2; J.G = gp; J.c = blockIdx.x; J.H = (const bf16_t*)(ws + WS_H); J.WT = (const bf16_t*)(ws + WS_WGU); J.ACT = ws + WS_ACTF;
        pg8::gemm_phase<JobGU, true>(lds, J, a.wv); } } SEAM(7);
    if (IN(8)) { PH_BEGIN JobRes<true, false> J; J.KB = FFD; J.ldab = FFD; J.ascale = 1.0f / (WSC * ASC); J.G = G; J.c = blockIdx.x; J.pool = 0; J.A = ws + WS_ACTF; J.Bt = ws + WS_WDN; J.xin = ws + WS_XR; J.xout = (bf16_t*)(ws + WS_XR); J.gate = mod + 5 * DM; J.cscale = nullptr; J.ssq2 = (float*)(ws + WS_SSQ2);
        pg8::gemm_phase<JobRes<true, false>, true>(lds, J, a.wv); } SEAM(8);
    if (IN(9)) { PH_BEGIN p8_pooldiff(a, lds, G); } SEAM(9);
    if (IN(10)) { PH_BEGIN JobRes<false, false> J; J.KB = 512; J.ldab = DM * 2; J.ascale = 1.0f; J.G = G; J.c = blockIdx.x; J.pool = 1; J.A = ws + WS_DIFF; J.Bt = ws + WS_WPOOL; J.xin = ws + WS_XR; J.xout = (bf16_t*)(ws + WS_XR); J.gate = mod + 5 * 6144 + 2 * DM; J.cscale = a.in[I_PSC]; J.ssq2 = nullptr;
        pg8::gemm_phase<JobRes<false, false>, true>(lds, J, a.wv); } SEAM(10);
    if (IN(11)) { PH_BEGIN p10_router(a, lds, G); } SEAM(11);
    if (IN(12)) { PH_BEGIN p10b_sort(a, lds, G); } SEAM(12);
    if (IN(13)) { PH_BEGIN JobMGU J; J.KB = DM; J.ldab = DM; J.c = blockIdx.x; J.T.init((const int*)(ws + WS_TOT)); J.XS = ws + WS_XS; J.WT = ws + WS_WMGU; J.ACT = ws + WS_BIG;
        const int gp = moe_gu_groups(J.T.p8, G), nh = G - gp, hq = moe_h3_quota(nh);
        J.G = gp;
        if ((int)blockIdx.x >= gp) moe_convert_range(a, lds, MOE_X2, MOE_X2 + hq, (int)blockIdx.x - gp, nh); else pg8::gemm_phase<JobMGU, true>(lds, J, a.wv); } SEAM(13);
    if (IN(14)) { PH_BEGIN JobMDown J; J.KB = FFE; J.ldab = FFE; J.G = G; J.c = blockIdx.x; J.T.init((const int*)(ws + WS_TOT)); J.ACT = ws + WS_BIG; J.WT = ws + WS_WMDN; J.Y = (bf16_t*)(ws + WS_Y); J.YS = (bf16_t*)(ws + WS_YS);
        J.nsplit = moe_nsplit(J.T.p8, G); J.nfull = J.T.p8 - J.nsplit;
        pg8::gemm_phase<JobMDown, true>(lds, J, a.wv); } SEAM(14);
    if (IN(15)) { PH_BEGIN p13_final(a, G, true); }
#undef IN
#undef SEAM
#undef PH_BEGIN
}

extern "C" void kernel_launch(void* const* d_in, const int* in_sizes, int n_in, void* d_out, int out_size, void* d_ws, size_t ws_size, hipStream_t stream) {
    static int grid = 0;
    if (grid == 0) {
        if (n_in != 22 || in_sizes[0] != MTOK * DM || out_size != MTOK * DM || ws_size < WS_END) { fprintf(stderr, "kernel_launch: unexpected shapes (n_in %d, in0 %d, out %d, ws %zu < %zu)\n", n_in, n_in > 0 ? in_sizes[0] : -1, out_size, ws_size, (size_t)WS_END); grid = -1; return; }
        int dev = 0, cus = 0, per_cu = 0;
        if (hipGetDevice(&dev) != hipSuccess || hipDeviceGetAttribute(&cus, hipDeviceAttributeMultiprocessorCount, dev) != hipSuccess) { grid = -1; return; }
        if (hipFuncSetAttribute((const void*)dit_fwd, hipFuncAttributeMaxDynamicSharedMemorySize, LDS_BYTES) != hipSuccess) { fprintf(stderr, "kernel_launch: hipFuncSetAttribute failed\n"); grid = -1; return; }
        if (hipOccupancyMaxActiveBlocksPerMultiprocessor(&per_cu, (const void*)dit_fwd, 512, LDS_BYTES) != hipSuccess || per_cu < 1) fprintf(stderr, "kernel_launch: occupancy query reports %d\n", per_cu);
        (void)hipGetLastError();
        grid = cus;
    }
    if (grid < 0) return;
    if (hipMemsetAsync((char*)d_ws + WS_CTL, 0, CTL_ZERO_BYTES, stream) != hipSuccess) return;
    Args a{};
    for (int i = 0; i < 22; ++i) a.in[i] = (const float*)d_in[i];
    a.out = (float*)d_out; a.ws = (unsigned char*)d_ws;
#if MK_ONE_LAUNCH
    a.ph_lo = 0; a.ph_hi = NPHASE;
    hipLaunchKernelGGL(dit_fwd, dim3(grid), dim3(512), LDS_BYTES, stream, a);
#else
    for (int p = 0; p < NPHASE; ++p) { a.ph_lo = p; a.ph_hi = p + 1; hipLaunchKernelGGL(dit_fwd, dim3(grid), dim3(512), LDS_BYTES, stream, a); }
#endif
}
```
